# Optimizing an MI355X kernel written in HIP

```python
import math
import jax, jax.numpy as jnp
from jax import lax
import numpy as np

D_MODEL = 2048
BATCH = 1
SEQ = 8192
DEPTH = 2
DEC_BATCH = 128
DEC_SEQ = 1
PAST_LEN = 8192
PAGE_SIZE = 128

HEAD_DIM = 128
RET_HEADS = D_MODEL // 2 // HEAD_DIM
RET_DK = HEAD_DIM
RET_DV = HEAD_DIM
RET_W = RET_HEADS * RET_DV
RET_CHUNK = 128
SWA_HEADS = D_MODEL // 2 // HEAD_DIM
SWA_KV_HEADS = 2
SWA_GROUP = SWA_HEADS // SWA_KV_HEADS
SWA_W = SWA_HEADS * HEAD_DIM
SWA_KV_W = SWA_KV_HEADS * HEAD_DIM
WINDOW = 128
MIX_W = RET_W + SWA_W
IN_SIZES = (RET_W, RET_W, RET_W, RET_W, SWA_W, SWA_KV_W, SWA_KV_W)
IN_W = RET_W * 4 + SWA_W + 2 * SWA_KV_W
MEM_LEN = 256
MEM_HEADS = 4
MEM_HD = 128
MEM_W = MEM_HEADS * MEM_HD
D_FF = ((8 * D_MODEL + 3 * 256 - 1) // (3 * 256)) * 256
ROPE_BASE = 10000.0
EPS = 1e-6

kernel_name = "hymba_retention_swa_sink_memxattn_step"


def rmsnorm(x, g):
    xf = x.astype(jnp.float32)
    y = xf * lax.rsqrt(jnp.mean(xf * xf, axis=-1, keepdims=True) + EPS)
    return (y * g.astype(jnp.float32)).astype(x.dtype)


def rotary(x, pos):
    half = x.shape[-1] // 2
    inv = ROPE_BASE ** (-jnp.arange(half, dtype=jnp.float32) / half)
    ang = pos.astype(jnp.float32)[:, None] * inv[None, :]
    cos = jnp.cos(ang)[None, :, None, :]
    sin = jnp.sin(ang)[None, :, None, :]
    xf = x.astype(jnp.float32)
    x1, x2 = xf[..., :half], xf[..., half:]
    return jnp.concatenate([x1 * cos - x2 * sin, x1 * sin + x2 * cos], axis=-1).astype(x.dtype)


def retention_log_decay():
    return jnp.log1p(-jnp.exp2(-5.0 - jnp.arange(RET_HEADS, dtype=jnp.float32)))


def retention(q, k, v, r0):
    B, L, H, DK = q.shape
    DV = v.shape[-1]
    f32 = jnp.float32
    C = RET_CHUNK if L % RET_CHUNK == 0 else L
    nc = L // C
    lg = retention_log_decay()
    idx = jnp.arange(C, dtype=f32)
    diff = idx[:, None] - idx[None, :]
    dmask = jnp.where(diff[None] >= 0, jnp.exp(lg[:, None, None] * jnp.maximum(diff, 0.0)[None]), 0.0)
    xi = jnp.exp(lg[:, None] * (idx + 1.0)[None])
    zeta = jnp.exp(lg[:, None] * (C - 1.0 - idx)[None])
    g_chunk = jnp.exp(lg * C)
    qc = q.astype(f32).reshape(B, nc, C, H, DK)
    kc = k.astype(f32).reshape(B, nc, C, H, DK)
    vc = v.astype(f32).reshape(B, nc, C, H, DV)
    s = jnp.einsum('bnchd,bnmhd->bnhcm', qc, kc) * dmask
    inner = jnp.einsum('bnhcm,bnmhv->bnchv', s, vc)
    kv = jnp.einsum('bnmhd,hm,bnmhv->nbhdv', kc, zeta, vc)

    def step(r, kv_n):
        return g_chunk[None, :, None, None] * r + kv_n, r

    r_last, r_prev = lax.scan(step, r0.astype(f32), kv)
    cross = jnp.einsum('bnchd,hc,nbhdv->bnchv', qc, xi, r_prev)
    out = (inner + cross).reshape(B, L, H, DV)
    return out, r_last


def sink_softmax(s, mask, sink):
    s = jnp.where(mask, s, -jnp.inf)
    sk = jnp.broadcast_to(sink.astype(jnp.float32).reshape(SWA_KV_HEADS, SWA_GROUP, 1, 1), s.shape[:-1] + (1,))
    p = jax.nn.softmax(jnp.concatenate([s, sk], axis=-1), axis=-1)
    return p[..., :-1]


def swa_prompt(q, k, v, sink):
    B, L, _, hd = q.shape
    W = WINDOW
    nb = L // W
    qb = q.reshape(B, nb, W, SWA_KV_HEADS, SWA_GROUP, hd)
    kb = k.reshape(B, nb, W, SWA_KV_HEADS, hd)
    vb = v.reshape(B, nb, W, SWA_KV_HEADS, hd)
    kk = jnp.concatenate([jnp.concatenate([jnp.zeros_like(kb[:, :1]), kb[:, :-1]], axis=1), kb], axis=2)
    vv = jnp.concatenate([jnp.concatenate([jnp.zeros_like(vb[:, :1]), vb[:, :-1]], axis=1), vb], axis=2)
    blk = jnp.arange(nb)[:, None] * W
    qpos = blk + jnp.arange(W)[None, :]
    kpos = blk - W + jnp.arange(2 * W)[None, :]
    d = qpos[:, :, None] - kpos[:, None, :]
    mask = (d >= 0) & (d <= WINDOW) & (kpos[:, None, :] >= 0)
    s = jnp.einsum('bnqkgd,bnskd->bnkgqs', qb, kk).astype(jnp.float32) * (hd ** -0.5)
    p = sink_softmax(s, mask[None, :, None, None], sink)
    o = jnp.einsum('bnkgqs,bnskd->bnqkgd', p.astype(vv.dtype), vv)
    return o.reshape(B, L, SWA_W)


def swa_decode(q, k, v, ck, cv, sink):
    B, T, _, hd = q.shape
    kk = jnp.concatenate([ck.astype(k.dtype), k], axis=1)
    vv = jnp.concatenate([cv.astype(v.dtype), v], axis=1)
    qpos = PAST_LEN + jnp.arange(T)
    kpos = jnp.concatenate([PAST_LEN - WINDOW + jnp.arange(WINDOW), PAST_LEN + jnp.arange(T)])
    d = qpos[:, None] - kpos[None, :]
    mask = (d >= 0) & (d <= WINDOW)
    qg = q.reshape(B, T, SWA_KV_HEADS, SWA_GROUP, hd)
    s = jnp.einsum('btkgd,bskd->bkgts', qg, kk).astype(jnp.float32) * (hd ** -0.5)
    p = sink_softmax(s, mask, sink)
    o = jnp.einsum('bkgts,bskd->btkgd', p.astype(vv.dtype), vv).reshape(B, T, SWA_W)
    return o, kk[:, -WINDOW:], vv[:, -WINDOW:]


def mixer(h, pos, w_in, ret_gn, sink, w_out, r0, ck, cv):
    B, L, _ = h.shape
    proj = h @ w_in
    splits = [int(s) for s in np.cumsum(IN_SIZES)[:-1]]
    rq, rk, rv, rg, sq, sk, sv = jnp.split(proj, splits, axis=-1)
    rq = rotary(rq.reshape(B, L, RET_HEADS, RET_DK), pos)
    rk = rotary(rk.reshape(B, L, RET_HEADS, RET_DK), pos) * (RET_DK ** -0.5)
    rv = rv.reshape(B, L, RET_HEADS, RET_DV)
    if r0 is None:
        r0 = jnp.zeros((B, RET_HEADS, RET_DK, RET_DV), jnp.float32)
    ro, r_new = retention(rq, rk, rv, r0)
    ro = ro * lax.rsqrt(jnp.mean(ro * ro, axis=-1, keepdims=True) + EPS)
    ro = ro.reshape(B, L, RET_W) * ret_gn.astype(jnp.float32)
    ro = (jax.nn.silu(rg.astype(jnp.float32)) * ro).astype(h.dtype)
    sq = sq.reshape(B, L, SWA_HEADS, HEAD_DIM)
    sk = sk.reshape(B, L, SWA_KV_HEADS, HEAD_DIM)
    sv = sv.reshape(B, L, SWA_KV_HEADS, HEAD_DIM)
    if ck is None:
        so = swa_prompt(sq, sk, sv, sink)
        nk, nv = sk[:, -WINDOW:], sv[:, -WINDOW:]
    else:
        so, nk, nv = swa_decode(sq, sk, sv, ck, cv, sink)
    y = jnp.concatenate([ro, so.astype(h.dtype)], axis=-1) @ w_out
    return y, r_new.astype(h.dtype), nk, nv


def cross_attn(h, mk, mv, wq, wo):
    B, L, _ = h.shape
    q = (h @ wq).reshape(B, L, MEM_HEADS, MEM_HD)
    s = jnp.einsum('blhd,bmhd->bhlm', q, mk.astype(q.dtype)).astype(jnp.float32) * (MEM_HD ** -0.5)
    p = jax.nn.softmax(s, axis=-1)
    o = jnp.einsum('bhlm,bmhd->blhd', p.astype(h.dtype), mv.astype(h.dtype)).reshape(B, L, MEM_W)
    return o @ wo


def run_trunk(x, pos, P, mem=None, state_ret=None, cache_win_k=None, cache_win_v=None,
              cache_mem_k=None, cache_mem_v=None):
    rs, ks, vs, mks, mvs = [], [], [], [], []
    for l in range(DEPTH):
        h = rmsnorm(x, P['g_mix'][l])
        r0 = None if state_ret is None else state_ret[l]
        ck = None if cache_win_k is None else cache_win_k[l]
        cv = None if cache_win_v is None else cache_win_v[l]
        y, r_new, nk, nv = mixer(h, pos, P['w_in'][l], P['ret_gn'][l], P['sinks'][l], P['w_out'][l], r0, ck, cv)
        x = x + y
        if mem is not None:
            mn = rmsnorm(mem, P['g_mem'][l])
            B = mem.shape[0]
            mk = (mn @ P['wk_c'][l]).reshape(B, MEM_LEN, MEM_HEADS, MEM_HD)
            mv = (mn @ P['wv_c'][l]).reshape(B, MEM_LEN, MEM_HEADS, MEM_HD)
        else:
            mk, mv = cache_mem_k[l], cache_mem_v[l]
        x = x + cross_attn(rmsnorm(x, P['g_cross'][l]), mk, mv, P['wq_c'][l], P['wo_c'][l])
        h = rmsnorm(x, P['g_ffn'][l])
        x = x + (jax.nn.silu(h @ P['w_gate'][l]) * (h @ P['w_up'][l])) @ P['w_down'][l]
        rs.append(r_new); ks.append(nk); vs.append(nv); mks.append(mk); mvs.append(mv)
    x = rmsnorm(x, P['g_final'])
    return x, rs, ks, vs, mks, mvs


def setup_inputs(seed: int = 0) -> dict:
    key = jax.random.key(seed)
    ks = jax.random.split(key, 32)
    f32 = jnp.float32
    nrm = lambda k, shape, scale: jax.random.normal(k, shape, f32) * scale
    gain = lambda k, shape: 1.0 + 0.02 * jax.random.normal(k, shape, f32)
    return {
        "x_prompt": nrm(ks[0], (BATCH, SEQ, D_MODEL), 1.0),
        "x_sample": nrm(ks[1], (DEC_BATCH, DEC_SEQ, D_MODEL), 1.0),
        "mem_prompt": nrm(ks[2], (BATCH, MEM_LEN, D_MODEL), 1.0),
        "state_ret": nrm(ks[3], (DEPTH, DEC_BATCH, RET_HEADS, RET_DK, RET_DV), 0.5),
        "cache_win_k": nrm(ks[4], (DEPTH, DEC_BATCH, WINDOW, SWA_KV_HEADS, HEAD_DIM), 1.0),
        "cache_win_v": nrm(ks[5], (DEPTH, DEC_BATCH, WINDOW, SWA_KV_HEADS, HEAD_DIM), 1.0),
        "cache_mem_k": nrm(ks[6], (DEPTH, DEC_BATCH, MEM_LEN, MEM_HEADS, MEM_HD), 1.0),
        "cache_mem_v": nrm(ks[7], (DEPTH, DEC_BATCH, MEM_LEN, MEM_HEADS, MEM_HD), 1.0),
        "g_mix": gain(ks[8], (DEPTH, D_MODEL)),
        "w_in": nrm(ks[9], (DEPTH, D_MODEL, IN_W), D_MODEL ** -0.5),
        "ret_gn": gain(ks[10], (DEPTH, RET_W)),
        "sinks": nrm(ks[11], (DEPTH, SWA_HEADS), 0.5),
        "w_out": nrm(ks[12], (DEPTH, MIX_W, D_MODEL), MIX_W ** -0.5),
        "g_cross": gain(ks[13], (DEPTH, D_MODEL)),
        "g_mem": gain(ks[14], (DEPTH, D_MODEL)),
        "wq_c": nrm(ks[15], (DEPTH, D_MODEL, MEM_W), D_MODEL ** -0.5),
        "wk_c": nrm(ks[16], (DEPTH, D_MODEL, MEM_W), D_MODEL ** -0.5),
        "wv_c": nrm(ks[17], (DEPTH, D_MODEL, MEM_W), D_MODEL ** -0.5),
        "wo_c": nrm(ks[18], (DEPTH, MEM_W, D_MODEL), MEM_W ** -0.5),
        "g_ffn": gain(ks[19], (DEPTH, D_MODEL)),
        "w_gate": nrm(ks[20], (DEPTH, D_MODEL, D_FF), D_MODEL ** -0.5),
        "w_up": nrm(ks[21], (DEPTH, D_MODEL, D_FF), D_MODEL ** -0.5),
        "w_down": nrm(ks[22], (DEPTH, D_FF, D_MODEL), D_FF ** -0.5),
        "g_final": gain(ks[23], (D_MODEL,)),
    }


def reference(x_prompt, x_sample, mem_prompt, state_ret, cache_win_k, cache_win_v, cache_mem_k, cache_mem_v,
              g_mix, w_in, ret_gn, sinks, w_out, g_cross, g_mem, wq_c, wk_c, wv_c, wo_c,
              g_ffn, w_gate, w_up, w_down, g_final):
    P = dict(g_mix=g_mix, w_in=w_in, ret_gn=ret_gn, sinks=sinks, w_out=w_out, g_cross=g_cross,
             g_mem=g_mem, wq_c=wq_c, wk_c=wk_c, wv_c=wv_c, wo_c=wo_c, g_ffn=g_ffn,
             w_gate=w_gate, w_up=w_up, w_down=w_down, g_final=g_final)
    pos_p = jnp.arange(x_prompt.shape[1], dtype=jnp.int32)
    y_prompt, rp, kp, vp, mkp, mvp = run_trunk(x_prompt, pos_p, P, mem=mem_prompt)
    pos_s = PAST_LEN + jnp.arange(x_sample.shape[1], dtype=jnp.int32)
    y_sample, rs, ks_, vs_, _, _ = run_trunk(x_sample, pos_s, P, state_ret=state_ret,
                                             cache_win_k=cache_win_k, cache_win_v=cache_win_v,
                                             cache_mem_k=cache_mem_k, cache_mem_v=cache_mem_v)
    return (y_prompt, y_sample,
            jnp.stack(rp), jnp.stack(kp), jnp.stack(vp), jnp.stack(mkp), jnp.stack(mvp),
            jnp.stack(rs), jnp.stack(ks_), jnp.stack(vs_))
```

```cpp
#define NLAYERS 2
#include <hip/hip_runtime.h>
#include <hip/hip_cooperative_groups.h>
#include <cstdio>
namespace cg = cooperative_groups;

#define LAS __attribute__((address_space(3)))
typedef unsigned short bf16_t;
typedef short bf16x8 __attribute__((ext_vector_type(8)));
typedef float f32x4 __attribute__((ext_vector_type(4)));
typedef unsigned u32x4 __attribute__((ext_vector_type(4)));
typedef unsigned u32x2 __attribute__((ext_vector_type(2)));

constexpr int DM = 2048, SEQ = 8192, NBAT = 128, MROWS = SEQ + NBAT  , MP = 8448  ;
constexpr int INW = 5632, DFF = 5632, MEMW = 512, MEML = 256;
constexpr float EPS = 1e-6f;
constexpr float QK_SCALE = 0.08838834764831845f;
constexpr int LDS_BYTES = 147456;

constexpr size_t OFF_YP = 0;
constexpr size_t OFF_YS = OFF_YP + (size_t)SEQ * DM;
constexpr size_t OFF_RETP = OFF_YS + (size_t)NBAT * DM;
constexpr size_t OFF_WKP = OFF_RETP + 2 * 8 * 128 * 128;
constexpr size_t OFF_WVP = OFF_WKP + 2 * 128 * 256;
constexpr size_t OFF_MKP = OFF_WVP + 2 * 128 * 256;
constexpr size_t OFF_MVP = OFF_MKP + 2 * 256 * 512;
constexpr size_t OFF_RETS = OFF_MVP + 2 * 256 * 512;
constexpr size_t OFF_WKS = OFF_RETS + (size_t)2 * 128 * 8 * 128 * 128;
constexpr size_t OFF_WVS = OFF_WKS + (size_t)2 * 128 * 128 * 256;
constexpr size_t OUT_TOTAL = OFF_WVS + (size_t)2 * 128 * 128 * 256;

constexpr size_t WS_X = 0;
constexpr size_t WS_H = WS_X + (size_t)MP * DM * 4;
constexpr size_t WS_PROJ = WS_H + (size_t)MP * DM * 2;
constexpr size_t WS_GU = WS_PROJ + (size_t)MP * INW * 2;
constexpr size_t WS_MIX = WS_GU + (size_t)MP * DFF * 2;
constexpr size_t WS_QC = WS_MIX + (size_t)MP * DM * 2;
constexpr size_t WS_OC = WS_QC + (size_t)MP * MEMW * 2;
constexpr size_t WS_KVT = WS_OC + (size_t)MP * MEMW * 2;
constexpr size_t WS_RT = WS_KVT + (size_t)64 * 8 * 16384 * 4;
constexpr size_t WS_MN = WS_RT + (size_t)64 * 8 * 16384 * 2;
constexpr size_t WS_MK = WS_MN + (size_t)2 * MEML * DM * 2;
constexpr size_t WS_MVT = WS_MK + (size_t)2 * MEML * MEMW * 2;
constexpr size_t WS_COS = WS_MVT + (size_t)2 * MEML * MEMW * 2;
constexpr size_t WS_SIN = WS_COS + (size_t)8256 * 64 * 4;
constexpr size_t WS_W = WS_SIN + (size_t)8256 * 64 * 4;
constexpr size_t W_IN = 0;
constexpr size_t W_OUT = W_IN + (size_t)INW * DM * 2;
constexpr size_t W_Q = W_OUT + (size_t)DM * DM * 2;
constexpr size_t W_K = W_Q + (size_t)MEMW * DM * 2;
constexpr size_t W_V = W_K + (size_t)MEMW * DM * 2;
constexpr size_t W_O = W_V + (size_t)MEMW * DM * 2;
constexpr size_t W_GU = W_O + (size_t)DM * MEMW * 2;
constexpr size_t W_D = W_GU + (size_t)2 * DFF * DM * 2;
constexpr size_t W_LAYER = W_D + (size_t)DM * DFF * 2;
constexpr size_t WS_BAR = WS_W + 2 * W_LAYER;
constexpr size_t WS_XB = WS_BAR + 16384;
constexpr size_t WS_PART = WS_XB + (size_t)SEQ * DM * 2;
constexpr size_t WS_END = WS_PART + (size_t)11 * 128 * DM * 4;

struct Args { const float* in[24]; float* out; unsigned char* ws; };

typedef __bf16 bf16x2_t __attribute__((ext_vector_type(2)));
__device__ __forceinline__ unsigned cvt_pk_bf16(float lo, float hi) { bf16x2_t v; v.x = (__bf16)lo; v.y = (__bf16)hi; return __builtin_bit_cast(unsigned, v); }
__device__ __forceinline__ bf16_t f2bf(float x) { return (bf16_t)(cvt_pk_bf16(x, 0.f) & 0xffffu); }
__device__ __forceinline__ float bf2f(unsigned h) { return __uint_as_float(h << 16); }
__device__ __forceinline__ float bflo(unsigned w) { return __uint_as_float(w << 16); }
__device__ __forceinline__ float bfhi(unsigned w) { return __uint_as_float(w & 0xffff0000u); }
__device__ __forceinline__ f32x4 mfma16(bf16x8 a, bf16x8 b, f32x4 c) { return __builtin_amdgcn_mfma_f32_16x16x32_bf16(a, b, c, 0, 0, 0); }
__device__ __forceinline__ bf16x8 ld8(const bf16_t* p) { return *reinterpret_cast<const bf16x8*>(p); }
__device__ __forceinline__ float red16_sum(float v) { v += __shfl_xor(v, 1); v += __shfl_xor(v, 2); v += __shfl_xor(v, 4); v += __shfl_xor(v, 8); return v; }
__device__ __forceinline__ float red16_max(float v) { v = fmaxf(v, __shfl_xor(v, 1)); v = fmaxf(v, __shfl_xor(v, 2)); v = fmaxf(v, __shfl_xor(v, 4)); v = fmaxf(v, __shfl_xor(v, 8)); return v; }
__device__ __forceinline__ float red64_sum(float v) { v = red16_sum(v); v += __shfl_xor(v, 16); v += __shfl_xor(v, 32); return v; }
__device__ __forceinline__ float red64_max(float v) { v = red16_max(v); v = fmaxf(v, __shfl_xor(v, 16)); v = fmaxf(v, __shfl_xor(v, 32)); return v; }
__device__ __forceinline__ float silu_f(float x) { return x * __builtin_amdgcn_rcpf(1.f + __expf(-x)); }
__device__ __forceinline__ int opaque_tid() { int t = threadIdx.x; asm volatile("" : "+v"(t)); return t; }
__device__ __forceinline__ int opaque_bid() { int b = blockIdx.x; asm volatile("" : "+s"(b)); return b; }
__device__ __forceinline__ float ret_lg2(int h) { return log1pf(-exp2f(-5.f - (float)h)) * 1.4426950408889634f; }

#define XB_TMO      128
#define XB_XCNT(j)  (256  + 64 * (j))
#define XB_XSUB(j)  (1280 + 64 * (j))
#define XB_XGEN(j)  (2304 + 64 * (j))
#define XB_TOP      3328
#define XB_TOPGEN   3392
#define XCD_BAR_WORDS 3456
#define XB_SPIN_CAP (1u << 18)

__device__ __forceinline__ unsigned xb_ld(unsigned* p)              { return __hip_atomic_load(p, __ATOMIC_RELAXED, __HIP_MEMORY_SCOPE_AGENT); }
__device__ __forceinline__ unsigned xb_add(unsigned* p, unsigned v) { return __hip_atomic_fetch_add(p, v, __ATOMIC_RELAXED, __HIP_MEMORY_SCOPE_AGENT); }
__device__ __forceinline__ unsigned xb_xcc_id() { return (unsigned)__builtin_amdgcn_s_getreg((3 << 11) | 20) & 0xFu; }
#define XB_SPIN(cond, bar) do { unsigned _sp = 0; while (cond) { __builtin_amdgcn_s_sleep(1); \
    if ((++_sp & 255u) == 0u) { if (xb_ld(&(bar)[XB_TMO])) break; if (_sp > XB_SPIN_CAP) { atomicAdd(&(bar)[XB_TMO], 1u); break; } } } } while (0)

struct XcdBarrier {
    unsigned* bar; unsigned x;
    volatile LAS unsigned* st;
};

__device__ __forceinline__ XcdBarrier xcd_barrier_post(unsigned* bar, volatile LAS unsigned* st) {
    XcdBarrier b; b.bar = bar; b.x = xb_xcc_id(); b.st = st;
    if (threadIdx.x == 0) (void)xb_add(&bar[XB_XCNT(b.x)], 1u);
    return b;
}
__device__ __forceinline__ void xcd_barrier_complete(unsigned* bar, unsigned x, unsigned& nloc, unsigned& nx) {
    const unsigned G = gridDim.x * gridDim.y * gridDim.z;
    unsigned sum, cnt, mine, sp = 0u;
    for (;;) {
        sum = 0u; cnt = 0u; mine = 0u;
#pragma unroll
        for (unsigned j = 0; j < 16; ++j) { const unsigned c = xb_ld(&bar[XB_XCNT(j)]); sum += c; cnt += (c > 0u) ? 1u : 0u; mine = (j == x) ? c : mine; }
        if (sum == G) break;
        __builtin_amdgcn_s_sleep(1);
        if ((++sp & 255u) == 0u) { if (xb_ld(&bar[XB_TMO])) break; if (sp > XB_SPIN_CAP) { atomicAdd(&bar[XB_TMO], 1u); break; } }
    }
    nloc = mine > 0u ? mine : 1u; nx = cnt > 0u ? cnt : 1u;
}

__device__ __forceinline__ void xcd_barrier(const XcdBarrier& b) {
    asm volatile("s_waitcnt vmcnt(0)" ::: "memory");
    __syncthreads();
    if (threadIdx.x == 0) {
        unsigned* bar = b.bar;
        __builtin_amdgcn_s_waitcnt(0);
        unsigned nloc = b.st[0], nx = b.st[1];
        if (nloc == 0u) { xcd_barrier_complete(bar, b.x, nloc, nx); b.st[0] = nloc; b.st[1] = nx; }
        const unsigned old = xb_add(&bar[XB_XSUB(b.x)], 1u);
        const unsigned gen = old / nloc;
        if (old + 1u == (gen + 1u) * nloc) {
            __builtin_amdgcn_fence(__ATOMIC_RELEASE, "agent");
            asm volatile("s_waitcnt vmcnt(0)" ::: "memory");
            const unsigned og = xb_add(&bar[XB_TOP], 1u);
            const unsigned tg = og / nx;
            if (og + 1u == (tg + 1u) * nx) xb_add(&bar[XB_TOPGEN], 1u);
            else XB_SPIN(xb_ld(&bar[XB_TOPGEN]) == tg, bar);
            __builtin_amdgcn_fence(__ATOMIC_ACQUIRE, "agent");
            xb_add(&bar[XB_XGEN(b.x)], 1u);
            asm volatile("s_waitcnt vmcnt(0)" ::: "memory");
        } else {
            XB_SPIN(xb_ld(&bar[XB_XGEN(b.x)]) == gen, bar);
            __builtin_amdgcn_fence(__ATOMIC_ACQUIRE, "agent");
            asm volatile("s_waitcnt vmcnt(0)" ::: "memory");
        }
    }
    __syncthreads();
}


namespace pg8 {
constexpr int BM = 256, BK = 64, HALF = 128, HTB = HALF * BK * 2, STAGE_BYTES = 8 * HTB, NXCD = 8, WGM = 8;
__device__ __forceinline__ int lds_byte(int r, int c) { const int st = (r >> 4) * 2 + (c >> 5), rr = r & 15, cc = c & 31, ob = rr * 64 + cc * 2; return st * 1024 + (ob ^ (((ob >> 9) & 1) << 5)); }
__device__ __forceinline__ void stage_rc(int b, int& R, int& C) { const int st = b / 1024, sb = b % 1024, swz = sb ^ (((sb >> 9) & 1) << 5); R = (st >> 1) * 16 + swz / 64; C = (st & 1) * 32 + (swz % 64) / 2; }
__device__ __forceinline__ int perm32(int rho) { const int n = rho >> 4, i = rho & 15; return 8 * (i >> 2) + 4 * n + (i & 3); }
struct Unit { int pm, pn; };
struct Gemm { const bf16_t* A; const bf16_t* Bt; int M, N, K, lda, ldb; };
struct StaticOrder {
    int nM, nN, nwg, G, c;
    __device__ void init(int M, int N, int G_, int c_) { nM = M / BM; nN = N / BM; nwg = nM * nN; G = G_; c = c_; }
    __device__ bool next(int i, Unit& u) const {
        const long L = (long)i * G + c; if (L >= nwg) return false;
        int wgid = (int)L; { const int q = nwg / NXCD, r = nwg % NXCD, xcd = wgid % NXCD, off = wgid / NXCD; wgid = (xcd < r ? xcd * (q + 1) : r * (q + 1) + (xcd - r) * q) + off; }
        const int nig = WGM * nN, gid = wgid / nig, fm = gid * WGM, gsz = (nM - fm) < WGM ? (nM - fm) : WGM;
        u.pm = fm + ((wgid % nig) % gsz); u.pn = (wgid % nig) / gsz; return true;
    }
    __device__ __forceinline__ void a_ready(const Unit&) const {}
    __device__ __forceinline__ void done(const Unit&) const {}
};

struct OneUnit {
    int pn;
    __device__ bool next(int i, Unit& u) const { if (i != 0) return false; u.pm = 0; u.pn = pn; return true; }
    __device__ __forceinline__ void a_ready(const Unit&) const {}
    __device__ __forceinline__ void done(const Unit&) const {}
};
template <class Epi, class Sched>
__device__ __forceinline__ void gemm_phase(LAS unsigned char* lds, const Gemm g, const Sched& S, const Epi& E) {
    const int tid = opaque_tid(), wid = __builtin_amdgcn_readfirstlane(tid >> 6), lane = tid & 63, wr = wid >> 2, wc = wid & 3, fr = lane & 15, fq = lane >> 4;
    const int K = g.K, nt = K / BK;
    unsigned voffA[2], voffB[2];
#pragma unroll
    for (int i = 0; i < 2; ++i) { int R, C; stage_rc(tid * 16 + i * 8192, R, C); const int Rb = Epi::PERM ? ((R & ~31) + perm32(R & 31)) : R;
        voffA[i] = (unsigned)(R * g.lda + C) * 2u; voffB[i] = (unsigned)(Rb * g.ldb + C) * 2u; }
    const size_t kstep = (size_t)(BK * 2);
    const size_t hstepA = (size_t)HALF * g.lda * 2, hstepB = (size_t)HALF * g.ldb * 2;
    const size_t tstepA = 2 * hstepA, tstepB = 2 * hstepB;
    const unsigned ldsw = (unsigned)wid * 1024u;
    const int aoff = lds_byte(wr * 64 + fr, fq * 8), boff = lds_byte(wc * 32 + fr, fq * 8);
#define PG8_SA(b, h) (((b) * 2 + (h)) * HTB)
#define PG8_SB(b, h) ((4 + (b) * 2 + (h)) * HTB)
#define PG8_STAGE(bufoff, gbase, voff) do { _Pragma("unroll") for (int _i = 0; _i < 2; ++_i) \
        __builtin_amdgcn_global_load_lds((const unsigned*)((const char*)(gbase) + (voff)[_i]), (LAS unsigned*)(lds + (bufoff) + ldsw + _i * 8192), 16, 0, 0); } while (0)
#define PG8_LDA(dst, b, h) do { _Pragma("unroll") for (int m = 0; m < 4; ++m) _Pragma("unroll") for (int k = 0; k < 2; ++k) dst[m][k] = *(const LAS bf16x8*)(lds + PG8_SA(b, h) + aoff + m * 2048 + k * 1024); } while (0)
#define PG8_LDB(dst, b, h) do { _Pragma("unroll") for (int n = 0; n < 2; ++n) _Pragma("unroll") for (int k = 0; k < 2; ++k) dst[n][k] = *(const LAS bf16x8*)(lds + PG8_SB(b, h) + boff + n * 2048 + k * 1024); } while (0)
#define PG8_MMA(ai, bj, At, Bt) do { __builtin_amdgcn_s_setprio(1); _Pragma("unroll") for (int m = 0; m < 4; ++m) _Pragma("unroll") for (int n = 0; n < 2; ++n) _Pragma("unroll") for (int k = 0; k < 2; ++k) \
        acc[ai][bj][m][n] = __builtin_amdgcn_mfma_f32_16x16x32_bf16(Bt[n][k], At[m][k], acc[ai][bj][m][n], 0, 0, 0); __builtin_amdgcn_s_setprio(0); } while (0)
#define PG8_WAIT_V(n) asm volatile("s_waitcnt vmcnt(" #n ")" ::: "memory")
#define PG8_WAIT_L(n) asm volatile("s_waitcnt lgkmcnt(" #n ")" ::: "memory")
#define PG8_BAR __builtin_amdgcn_s_barrier()
#define PG8_SCHED __builtin_amdgcn_sched_barrier(0)
    Unit cur, nxt; int ui = 0;
    if (!S.next(0, cur)) return;
    f32x4 acc[2][2][4][2];
#pragma unroll
    for (int a = 0; a < 2; ++a)
#pragma unroll
        for (int b = 0; b < 2; ++b)
#pragma unroll
            for (int m = 0; m < 4; ++m)
#pragma unroll
                for (int n = 0; n < 2; ++n) acc[a][b][m][n] = (f32x4){0.f, 0.f, 0.f, 0.f};
    bf16x8 At[4][2], B0[2][2], B1[2][2];
    const char* cA = (const char*)g.A + (size_t)cur.pm * tstepA; const char* cB = (const char*)g.Bt + (size_t)cur.pn * tstepB;
    S.a_ready(cur);
    PG8_STAGE(PG8_SB(0, 0), cB, voffB); PG8_STAGE(PG8_SA(0, 0), cA, voffA); PG8_STAGE(PG8_SB(0, 1), cB + hstepB, voffB); PG8_STAGE(PG8_SA(0, 1), cA + hstepA, voffA);
    if (wr == 1) PG8_BAR;
    PG8_WAIT_V(4); PG8_BAR;
    PG8_STAGE(PG8_SB(1, 0), cB + kstep, voffB); PG8_STAGE(PG8_SA(1, 0), cA + kstep, voffA); PG8_STAGE(PG8_SB(1, 1), cB + hstepB + kstep, voffB);
    PG8_WAIT_V(6); PG8_BAR;
    for (;;) {
        const bool has_next = S.next(ui + 1, nxt);
        const char* nA = has_next ? (const char*)g.A + (size_t)nxt.pm * tstepA : cA; const char* nB = has_next ? (const char*)g.Bt + (size_t)nxt.pn * tstepB : cB;
        for (int t = 0; t < nt; t += 2) {
            const bool last = (t == nt - 2);
            const char* a1 = cA + (size_t)(t + 1) * kstep;
            const char* a2 = last ? nA : cA + (size_t)(t + 2) * kstep; const char* b2 = last ? nB : cB + (size_t)(t + 2) * kstep;
            const char* a3 = a2 + kstep; const char* b3 = b2 + kstep;
            if (last && has_next) S.a_ready(nxt);
            PG8_LDB(B0, 0, 0); PG8_SCHED; PG8_LDA(At, 0, 0); PG8_STAGE(PG8_SA(1, 1), a1 + hstepA, voffA);
            PG8_WAIT_L(8); PG8_BAR; PG8_WAIT_L(0); PG8_MMA(0, 0, At, B0); PG8_BAR; PG8_SCHED;
            PG8_LDB(B1, 0, 1); PG8_STAGE(PG8_SB(0, 0), b2, voffB);
            PG8_BAR; PG8_WAIT_L(0); PG8_MMA(0, 1, At, B1); PG8_BAR;
            PG8_LDA(At, 0, 1); PG8_STAGE(PG8_SA(0, 0), a2, voffA);
            PG8_BAR; PG8_WAIT_L(0); PG8_MMA(1, 0, At, B0); PG8_BAR; PG8_SCHED;
            PG8_STAGE(PG8_SB(0, 1), b2 + hstepB, voffB);
            PG8_WAIT_V(6); PG8_BAR; PG8_MMA(1, 1, At, B1); PG8_BAR;
            PG8_LDB(B0, 1, 0); PG8_SCHED; PG8_LDA(At, 1, 0); PG8_STAGE(PG8_SA(0, 1), a2 + hstepA, voffA);
            PG8_WAIT_L(8); PG8_BAR; PG8_WAIT_L(0); PG8_MMA(0, 0, At, B0); PG8_BAR; PG8_SCHED;
            PG8_LDB(B1, 1, 1); PG8_STAGE(PG8_SB(1, 0), b3, voffB);
            PG8_BAR; PG8_WAIT_L(0); PG8_MMA(0, 1, At, B1); PG8_BAR;
            PG8_LDA(At, 1, 1); PG8_STAGE(PG8_SA(1, 0), a3, voffA);
            PG8_BAR; PG8_WAIT_L(0); PG8_MMA(1, 0, At, B0); PG8_BAR; PG8_SCHED;
            PG8_STAGE(PG8_SB(1, 1), b3 + hstepB, voffB);
            PG8_WAIT_V(6); PG8_BAR; PG8_MMA(1, 1, At, B1); PG8_BAR;
        }
        E(acc, cur, wr, wc, fr, fq); S.done(cur);
        if (!has_next) break;
#pragma unroll
        for (int a = 0; a < 2; ++a)
#pragma unroll
            for (int b = 0; b < 2; ++b)
#pragma unroll
                for (int m = 0; m < 4; ++m)
#pragma unroll
                    for (int n = 0; n < 2; ++n) acc[a][b][m][n] = (f32x4){0.f, 0.f, 0.f, 0.f};
        cur = nxt; cA = nA; cB = nB; ++ui;
    }
    PG8_WAIT_V(0);
    if (wr == 0) PG8_BAR;
    PG8_BAR;
#undef PG8_SA
#undef PG8_SB
#undef PG8_STAGE
#undef PG8_LDA
#undef PG8_LDB
#undef PG8_MMA
#undef PG8_WAIT_V
#undef PG8_WAIT_L
#undef PG8_BAR
#undef PG8_SCHED
}

struct EpiRes {
    static constexpr bool PERM = false;
    float* X; int ldc;
    __device__ __forceinline__ void operator()(const f32x4 (&acc)[2][2][4][2], const Unit& u, int wr, int wc, int fr, int fq) const {
        const int row0 = u.pm * BM + wr * 64 + fr, col0 = u.pn * BM + wc * 32 + 4 * fq;
#pragma unroll
        for (int ai = 0; ai < 2; ++ai)
#pragma unroll
            for (int m = 0; m < 4; ++m) { float* rowp = X + (size_t)(row0 + ai * HALF + m * 16) * ldc + col0;
                f32x4 o[2][2];
#pragma unroll
                for (int bj = 0; bj < 2; ++bj)
#pragma unroll
                    for (int n = 0; n < 2; ++n) o[bj][n] = *(const f32x4*)(rowp + bj * HALF + n * 16);
#pragma unroll
                for (int bj = 0; bj < 2; ++bj)
#pragma unroll
                    for (int n = 0; n < 2; ++n) *(f32x4*)(rowp + bj * HALF + n * 16) = o[bj][n] + acc[ai][bj][m][n];
                asm volatile("" ::: "memory"); }
    }
};
struct EpiResB {
    static constexpr bool PERM = true;
    bf16_t* XB; int ldc;
    __device__ __forceinline__ void operator()(const f32x4 (&acc)[2][2][4][2], const Unit& u, int wr, int wc, int fr, int fq) const {
        const int row0 = u.pm * BM + wr * 64 + fr, col0 = u.pn * BM + wc * 32 + 8 * fq;
#pragma unroll
        for (int ai = 0; ai < 2; ++ai) {
            u32x4 o[4][2];
#pragma unroll
            for (int m = 0; m < 4; ++m)
#pragma unroll
                for (int bj = 0; bj < 2; ++bj) o[m][bj] = *(const u32x4*)(XB + (size_t)(row0 + ai * HALF + m * 16) * ldc + col0 + bj * HALF);
            asm volatile("" ::: "memory");
#pragma unroll
            for (int m = 0; m < 4; ++m)
#pragma unroll
                for (int bj = 0; bj < 2; ++bj) { const u32x4 x = o[m][bj]; const f32x4 v0 = acc[ai][bj][m][0], v1 = acc[ai][bj][m][1];
                    u32x4 w; w.x = cvt_pk_bf16(bflo(x.x) + v0[0], bfhi(x.x) + v0[1]); w.y = cvt_pk_bf16(bflo(x.y) + v0[2], bfhi(x.y) + v0[3]);
                    w.z = cvt_pk_bf16(bflo(x.z) + v1[0], bfhi(x.z) + v1[1]); w.w = cvt_pk_bf16(bflo(x.w) + v1[2], bfhi(x.w) + v1[3]);
                    *(u32x4*)(XB + (size_t)(row0 + ai * HALF + m * 16) * ldc + col0 + bj * HALF) = w; }
            asm volatile("" ::: "memory"); }
    }
};
struct EpiResPart {
    static constexpr bool PERM = false;
    float* P; int ldc;
    __device__ __forceinline__ void operator()(const f32x4 (&acc)[2][2][4][2], const Unit& u, int wr, int wc, int fr, int fq) const {
        const int row0 = wr * 64 + fr, col0 = u.pn * BM + wc * 32 + 4 * fq;
#pragma unroll
        for (int m = 0; m < 4; ++m) { float* rowp = P + (size_t)(row0 + m * 16) * ldc + col0;
#pragma unroll
            for (int bj = 0; bj < 2; ++bj)
#pragma unroll
                for (int n = 0; n < 2; ++n) *(f32x4*)(rowp + bj * HALF + n * 16) = acc[0][bj][m][n]; }
    }
};
struct EpiResAtomic {
    static constexpr bool PERM = false;
    float* X; int ldc;
    __device__ __forceinline__ void operator()(const f32x4 (&acc)[2][2][4][2], const Unit& u, int wr, int wc, int fr, int fq) const {
        const int row0 = wr * 64 + fr, col0 = u.pn * BM + wc * 32 + 4 * fq;
#pragma unroll
        for (int m = 0; m < 4; ++m) { float* rowp = X + (size_t)(row0 + m * 16) * ldc + col0;
#pragma unroll
            for (int bj = 0; bj < 2; ++bj)
#pragma unroll
                for (int n = 0; n < 2; ++n)
#pragma unroll
                    for (int j = 0; j < 4; ++j) __hip_atomic_fetch_add(rowp + bj * HALF + n * 16 + j, acc[0][bj][m][n][j], __ATOMIC_RELAXED, __HIP_MEMORY_SCOPE_AGENT); }
    }
};
struct EpiBf {
    static constexpr bool PERM = true;
    bf16_t* O; int ldc;
    __device__ __forceinline__ void operator()(const f32x4 (&acc)[2][2][4][2], const Unit& u, int wr, int wc, int fr, int fq) const {
        const int row0 = u.pm * BM + wr * 64 + fr, col0 = u.pn * BM + wc * 32 + 8 * fq;
#pragma unroll
        for (int ai = 0; ai < 2; ++ai)
#pragma unroll
            for (int m = 0; m < 4; ++m) { bf16_t* rowp = O + (size_t)(row0 + ai * HALF + m * 16) * ldc + col0;
#pragma unroll
                for (int bj = 0; bj < 2; ++bj) { const f32x4 v0 = acc[ai][bj][m][0], v1 = acc[ai][bj][m][1];
                    u32x4 w; w.x = cvt_pk_bf16(v0[0], v0[1]); w.y = cvt_pk_bf16(v0[2], v0[3]); w.z = cvt_pk_bf16(v1[0], v1[1]); w.w = cvt_pk_bf16(v1[2], v1[3]);
                    *(u32x4*)(rowp + bj * HALF) = w; } }
    }
};
struct EpiMem {
    static constexpr bool PERM = false;
    float* C; bf16_t* O; int ldc;
    __device__ __forceinline__ void operator()(const f32x4 (&acc)[2][2][4][2], const Unit& u, int wr, int wc, int fr, int fq) const {
        const int row0 = u.pm * BM + wr * 64 + fr, col0 = u.pn * BM + wc * 32 + 4 * fq;
#pragma unroll
        for (int ai = 0; ai < 2; ++ai)
#pragma unroll
            for (int m = 0; m < 4; ++m) { const size_t ro = (size_t)(row0 + ai * HALF + m * 16) * ldc + col0;
#pragma unroll
                for (int bj = 0; bj < 2; ++bj)
#pragma unroll
                    for (int n = 0; n < 2; ++n) { const f32x4 v = acc[ai][bj][m][n]; *(f32x4*)(C + ro + bj * HALF + n * 16) = v;
                        if (O) { u32x2 w; w.x = cvt_pk_bf16(v[0], v[1]); w.y = cvt_pk_bf16(v[2], v[3]); *(u32x2*)(O + ro + bj * HALF + n * 16) = w; } } }
    }
};
struct EpiGU {
    static constexpr bool PERM = true;
    bf16_t* O;
    __device__ __forceinline__ void operator()(const f32x4 (&acc)[2][2][4][2], const Unit& u, int wr, int wc, int fr, int fq) const {
        const int row0 = u.pm * BM + wr * 64 + fr, col0 = u.pn * 128 + wc * 16 + 4 * fq;
#pragma unroll
        for (int ai = 0; ai < 2; ++ai)
#pragma unroll
            for (int m = 0; m < 4; ++m) { bf16_t* rowp = O + (size_t)(row0 + ai * HALF + m * 16) * DFF + col0;
#pragma unroll
                for (int bj = 0; bj < 2; ++bj) { const f32x4 v0 = acc[ai][bj][m][0], v1 = acc[ai][bj][m][1];
                    u32x2 w; w.x = cvt_pk_bf16(silu_f(v0[0]) * v0[1], silu_f(v0[2]) * v0[3]); w.y = cvt_pk_bf16(silu_f(v1[0]) * v1[1], silu_f(v1[2]) * v1[3]);
                    *(u32x2*)(rowp + bj * 64) = w; } }
    }
};
struct EpiIn {
    static constexpr bool PERM = true;
    bf16_t* P; const float* cs; const float* sn; float* out; int layer;
    __device__ __forceinline__ void operator()(const f32x4 (&acc)[2][2][4][2], const Unit& u, int wr, int wc, int fr, int fq) const {
        const int pn = u.pn, cin = wc * 32 + 8 * fq, rbase = u.pm * BM + wr * 64 + fr;
        const bool rot = pn < 8; const float sc = (pn >= 4 && pn < 8) ? QK_SCALE : 1.f;
#pragma unroll
        for (int ai = 0; ai < 2; ++ai)
#pragma unroll
            for (int m = 0; m < 4; ++m) { const int r = rbase + ai * HALF + m * 16; const int pos = r < SEQ ? r : SEQ;
                f32x4 c4 = (f32x4){1.f, 1.f, 1.f, 1.f}, s4 = (f32x4){0.f, 0.f, 0.f, 0.f};
                if (rot) { c4 = *(const f32x4*)(cs + (size_t)pos * 64 + (cin >> 1)); s4 = *(const f32x4*)(sn + (size_t)pos * 64 + (cin >> 1)); }
#pragma unroll
                for (int bj = 0; bj < 2; ++bj) { const f32x4 v0 = acc[ai][bj][m][0], v1 = acc[ai][bj][m][1];
                    const int cc = bj * HALF + cin;
                    float o[8];
                    o[0] = (v0[0] * c4[0] - v0[1] * s4[0]) * sc; o[1] = (v0[0] * s4[0] + v0[1] * c4[0]) * sc;
                    o[2] = (v0[2] * c4[1] - v0[3] * s4[1]) * sc; o[3] = (v0[2] * s4[1] + v0[3] * c4[1]) * sc;
                    o[4] = (v1[0] * c4[2] - v1[1] * s4[2]) * sc; o[5] = (v1[0] * s4[2] + v1[1] * c4[2]) * sc;
                    o[6] = (v1[2] * c4[3] - v1[3] * s4[3]) * sc; o[7] = (v1[2] * s4[3] + v1[3] * c4[3]) * sc;
                    if (!rot) { o[0] = v0[0]; o[1] = v0[1]; o[2] = v0[2]; o[3] = v0[3]; o[4] = v1[0]; o[5] = v1[1]; o[6] = v1[2]; o[7] = v1[3]; }
                    u32x4 w; w.x = cvt_pk_bf16(o[0], o[1]); w.y = cvt_pk_bf16(o[2], o[3]); w.z = cvt_pk_bf16(o[4], o[5]); w.w = cvt_pk_bf16(o[6], o[7]);
                    *(u32x4*)(P + (size_t)r * INW + pn * BM + cc) = w;
                    if (pn >= 20) {
                        float* dst = nullptr;
                        if (r >= SEQ - 128 && r < SEQ) dst = out + OFF_WKP + (size_t)(pn - 20) * 65536 + (size_t)layer * 32768 + (size_t)(r - (SEQ - 128)) * 256 + cc;
                        else if (r >= SEQ && r < MROWS) dst = out + OFF_WKS + (size_t)(pn - 20) * 8388608 + ((size_t)(layer * 128 + (r - SEQ)) * 128 + 127) * 256 + cc;
                        if (dst) { *(f32x4*)dst = v0; *(f32x4*)(dst + 4) = v1; }
                    } } }
    }
};
}

__device__ __forceinline__ int rowmap(int mode, int n) {
    if (mode == 1) { if (n < 2048) { const int hd = n >> 7, d = n & 127; return (hd << 7) + ((d & 63) << 1) + (d >> 6); } return n; }
    if (mode == 2) return 2 * n;
    if (mode == 3) return 2 * n + 1;
    return n;
}
__device__ void convT(const float* __restrict__ src, int K, int N, bf16_t* __restrict__ dst, int mode, float* tile  , int brot, int vb, int vG) {
    const int TX = opaque_tid(); const int BX = opaque_bid(); (void)BX;
    const int tn = N >> 7, tk = K >> 6, nt = tn * tk, t = TX;
    const int n4 = (t & 31) * 4, kk = t >> 5;
    const int sn = t >> 2, kc = (t & 3) * 16;
    int ti = (vb + brot) % vG;
    f32x4 v[4];
    if (ti < nt) { const int k0 = (ti / tn) << 6, n0 = (ti % tn) << 7;
#pragma unroll
        for (int i = 0; i < 4; ++i) v[i] = *(const f32x4*)(src + (size_t)(k0 + kk + 16 * i) * N + n0 + n4); }
    for (; ti < nt; ti += vG) {
        const int k0 = (ti / tn) << 6, n0 = (ti % tn) << 7;
        const int tnx = ti + vG;
        f32x4 nv[4];
        if (tnx < nt) { const int k1 = (tnx / tn) << 6, n1 = (tnx % tn) << 7;
#pragma unroll
            for (int i = 0; i < 4; ++i) nv[i] = *(const f32x4*)(src + (size_t)(k1 + kk + 16 * i) * N + n1 + n4); }
        else {
#pragma unroll
            for (int i = 0; i < 4; ++i) nv[i] = (f32x4){0.f, 0.f, 0.f, 0.f}; }
        __syncthreads();
#pragma unroll
        for (int i = 0; i < 4; ++i)
#pragma unroll
            for (int j = 0; j < 4; ++j) tile[(n4 + j) * 65 + kk + 16 * i] = v[i][j];
        __syncthreads();
        const float* tp = tile + sn * 65 + kc;
        u32x4 w0, w1;
        w0.x = cvt_pk_bf16(tp[0], tp[1]); w0.y = cvt_pk_bf16(tp[2], tp[3]); w0.z = cvt_pk_bf16(tp[4], tp[5]); w0.w = cvt_pk_bf16(tp[6], tp[7]);
        w1.x = cvt_pk_bf16(tp[8], tp[9]); w1.y = cvt_pk_bf16(tp[10], tp[11]); w1.z = cvt_pk_bf16(tp[12], tp[13]); w1.w = cvt_pk_bf16(tp[14], tp[15]);
        bf16_t* dp = dst + (size_t)rowmap(mode, n0 + sn) * K + k0 + kc;
        *(u32x4*)dp = w0; *(u32x4*)(dp + 8) = w1;
#pragma unroll
        for (int i = 0; i < 4; ++i) v[i] = nv[i];
    }
    __syncthreads();
}

__device__ void rms_phase(const Args& a, int mode, const float* __restrict__ g, int nparts) {
    const int TX = opaque_tid(); const int BX = opaque_bid(); (void)BX;
    float* X = (float*)(a.ws + WS_X); bf16_t* H = (bf16_t*)(a.ws + WS_H); bf16_t* XB = (bf16_t*)(a.ws + WS_XB);
    const int lane = TX & 63, gw = BX * 8 + (TX >> 6), nw = gridDim.x * 8;
    for (int r = gw; r < MP; r += nw) {
        if (mode == 2 && r >= MROWS) continue;
        f32x4 v[8]; float ss = 0.f;
        if (mode != 0 && r < SEQ) {
#pragma unroll
            for (int ch = 0; ch < 4; ++ch) { const u32x4 raw = *(const u32x4*)(XB + (size_t)r * DM + ch * 512 + lane * 8);
                v[2 * ch] = (f32x4){bflo(raw.x), bfhi(raw.x), bflo(raw.y), bfhi(raw.y)}; v[2 * ch + 1] = (f32x4){bflo(raw.z), bfhi(raw.z), bflo(raw.w), bfhi(raw.w)}; }
        } else {
            const float* src = nullptr;
            if (mode == 0) { if (r < SEQ) src = a.in[0] + (size_t)r * DM; else if (r < MROWS) src = a.in[1] + (size_t)(r - SEQ) * DM; }
            else src = X + (size_t)r * DM;
#pragma unroll
            for (int ch = 0; ch < 4; ++ch) { const int col = ch * 512 + lane * 8;
                if (src) { v[2 * ch] = *(const f32x4*)(src + col); v[2 * ch + 1] = *(const f32x4*)(src + col + 4); }
                else { v[2 * ch] = (f32x4){0.f, 0.f, 0.f, 0.f}; v[2 * ch + 1] = (f32x4){0.f, 0.f, 0.f, 0.f}; } }
            if (mode != 0 && nparts > 0 && r < MROWS) {
                const float* part = (const float*)(a.ws + WS_PART) + (size_t)(r - SEQ) * DM;
                for (int ks = 0; ks < nparts; ++ks) {
#pragma unroll
                    for (int ch = 0; ch < 4; ++ch) { const int col = ch * 512 + lane * 8;
                        v[2 * ch] += *(const f32x4*)(part + (size_t)ks * 128 * DM + col); v[2 * ch + 1] += *(const f32x4*)(part + (size_t)ks * 128 * DM + col + 4); } }
#pragma unroll
                for (int ch = 0; ch < 4; ++ch) { const int col = ch * 512 + lane * 8;
                    *(f32x4*)(X + (size_t)r * DM + col) = v[2 * ch]; *(f32x4*)(X + (size_t)r * DM + col + 4) = v[2 * ch + 1]; } }
        }
#pragma unroll
        for (int i = 0; i < 8; ++i)
#pragma unroll
            for (int j = 0; j < 4; ++j) ss += v[i][j] * v[i][j];
        ss = red64_sum(ss);
        const float rstd = rsqrtf(ss * (1.f / DM) + EPS);
#pragma unroll
        for (int ch = 0; ch < 4; ++ch) { const int col = ch * 512 + lane * 8;
            const f32x4 g0 = *(const f32x4*)(g + col), g1 = *(const f32x4*)(g + col + 4);
            const f32x4 y0 = v[2 * ch] * rstd * g0, y1 = v[2 * ch + 1] * rstd * g1;
            if (mode == 0) {
                if (r < SEQ) { u32x4 w; w.x = cvt_pk_bf16(v[2 * ch][0], v[2 * ch][1]); w.y = cvt_pk_bf16(v[2 * ch][2], v[2 * ch][3]); w.z = cvt_pk_bf16(v[2 * ch + 1][0], v[2 * ch + 1][1]); w.w = cvt_pk_bf16(v[2 * ch + 1][2], v[2 * ch + 1][3]);
                    *(u32x4*)(XB + (size_t)r * DM + col) = w; }
                else { *(f32x4*)(X + (size_t)r * DM + col) = v[2 * ch]; *(f32x4*)(X + (size_t)r * DM + col + 4) = v[2 * ch + 1]; } }
            if (mode == 2) { *(f32x4*)(a.out + (size_t)r * DM + col) = y0; *(f32x4*)(a.out + (size_t)r * DM + col + 4) = y1; }
            else { u32x4 w; w.x = cvt_pk_bf16(y0[0], y0[1]); w.y = cvt_pk_bf16(y0[2], y0[3]); w.z = cvt_pk_bf16(y1[0], y1[1]); w.w = cvt_pk_bf16(y1[2], y1[3]);
                *(u32x4*)(H + (size_t)r * DM + col) = w; } }
    }
}

__device__ __forceinline__ void load_T128(const bf16_t* __restrict__ src, size_t ld, bf16_t* dst, int dstStride, int colOff, bool zeta, float lg2, bool zero) {
    const int TX = opaque_tid(); const int BX = opaque_bid(); (void)BX;
    const int t = TX;
#pragma unroll
    for (int i = 0; i < 4; ++i) {
        const int m = (t & 31) + 32 * i, c8 = (t >> 5) * 8;
        u32x4 raw = (u32x4){0u, 0u, 0u, 0u};
        if (!zero) raw = *(const u32x4*)(src + (size_t)m * ld + c8);
        const float sc = zeta ? exp2f(lg2 * (float)(127 - m)) : 1.f;
#pragma unroll
        for (int e = 0; e < 4; ++e) { const unsigned w = raw[e];
            bf16_t lo = (bf16_t)(w & 0xffffu), hi = (bf16_t)(w >> 16);
            if (zeta) { lo = f2bf(bflo(w) * sc); hi = f2bf(bfhi(w) * sc); }
            dst[(c8 + 2 * e) * dstStride + colOff + m] = lo; dst[(c8 + 2 * e + 1) * dstStride + colOff + m] = hi; }
    }
}


template <int NROWS, int CPR>
__device__ __forceinline__ void stage_rows(const bf16_t* __restrict__ src, size_t ld, bf16_t* dst, int dstStride, int tx) {
    constexpr int TOT = NROWS * CPR;
#pragma unroll
    for (int i = 0; i < TOT / 512; ++i) { const int q = tx + 512 * i, r = q / CPR, c = q % CPR;
        *(u32x4*)(dst + r * dstStride + c * 8) = *(const u32x4*)(src + (size_t)r * ld + c * 8); }
}


typedef short v4s_t __attribute__((ext_vector_type(4)));
__device__ __forceinline__ bf16x8 ld8_tr(const bf16_t* tile, int row0, int stride, int col0, int fq, int fr) {
    typedef __attribute__((address_space(3))) v4s_t* lp_t;
    const int q = fr >> 2, p = fr & 3;
    const v4s_t lo = __builtin_amdgcn_ds_read_tr16_b64_v4i16((lp_t)(tile + (row0 + 8 * fq + q) * stride + col0 + 4 * p));
    const v4s_t hi = __builtin_amdgcn_ds_read_tr16_b64_v4i16((lp_t)(tile + (row0 + 8 * fq + 4 + q) * stride + col0 + 4 * p));
    return (bf16x8){lo[0], lo[1], lo[2], lo[3], hi[0], hi[1], hi[2], hi[3]};
}
template <int NROWS, int CPR>
__device__ __forceinline__ void zero_rows(bf16_t* dst, int dstStride, int tx) {
#pragma unroll
    for (int i = 0; i < NROWS * CPR / 512; ++i) { const int q = tx + 512 * i, r = q / CPR, c = q % CPR; *(u32x4*)(dst + r * dstStride + c * 8) = (u32x4){0u, 0u, 0u, 0u}; }
}

__device__ __forceinline__ void ret_kv_item(const Args& a, int n, int h, unsigned char* shm) {
    const int TX = opaque_tid(); const int BX = opaque_bid(); (void)BX;
    const bf16_t* PROJ = (const bf16_t*)(a.ws + WS_PROJ); float* KVT = (float*)(a.ws + WS_KVT);
    bf16_t* kT = (bf16_t*)shm; bf16_t* vT = kT + 128 * 136;
    const int lane = TX & 63, w = TX >> 6, fr = lane & 15, fq = lane >> 4;
    const float lg2 = ret_lg2(h);
    const bf16_t* base = PROJ + (size_t)(n * 128) * INW + h * 128;
    __syncthreads();
    load_T128(base + 1024, INW, kT, 136, 0, true, lg2, false);
    load_T128(base + 2048, INW, vT, 136, 0, false, 0.f, false);
    __syncthreads();
    f32x4 acc[8];
#pragma unroll
    for (int t = 0; t < 8; ++t) acc[t] = (f32x4){0.f, 0.f, 0.f, 0.f};
#pragma unroll
    for (int ks = 0; ks < 4; ++ks) { const bf16x8 av = ld8(vT + (16 * w + fr) * 136 + ks * 32 + fq * 8);
#pragma unroll
        for (int t = 0; t < 8; ++t) acc[t] = mfma16(av, ld8(kT + (16 * t + fr) * 136 + ks * 32 + fq * 8), acc[t]); }
    float* dst = KVT + ((size_t)(n * 8 + h) << 14);
#pragma unroll
    for (int t = 0; t < 8; ++t)
#pragma unroll
        for (int j = 0; j < 4; ++j) dst[(16 * w + fq * 4 + j) * 128 + 16 * t + fr] = acc[t][j];
}

__device__ void ret_scan_phase(const Args& a, int l) {
    const int TX = opaque_tid(); const int BX = opaque_bid(); (void)BX;
    float* KVT = (float*)(a.ws + WS_KVT); bf16_t* RT = (bf16_t*)(a.ws + WS_RT);
    for (int e = BX * 512 + TX; e < 8 * 16384; e += gridDim.x * 512) {
        const int h = e >> 14, rem = e & 16383;
        const float g = exp2f(ret_lg2(h) * 128.f);
        float r = 0.f;
#pragma unroll 8
        for (int n = 0; n < 64; ++n) { const size_t off = ((size_t)(n * 8 + h) << 14) + rem; const float kv = KVT[off]; RT[off] = f2bf(r); r = g * r + kv; }
        const int dv = rem >> 7, p = rem & 127, dt = (p >> 1) + 64 * (p & 1);
        a.out[OFF_RETP + (size_t)l * 131072 + (size_t)(h * 128 + dt) * 128 + dv] = r;
    }
}

__device__ __forceinline__ void ret_out_item(const Args& a, int l, int n, int h, unsigned char* shm) {
    const int TX = opaque_tid(); const int BX = opaque_bid(); (void)BX;
    const bf16_t* PROJ = (const bf16_t*)(a.ws + WS_PROJ); const bf16_t* RT = (const bf16_t*)(a.ws + WS_RT); bf16_t* MIX = (bf16_t*)(a.ws + WS_MIX);
    const int lane = TX & 63, w = __builtin_amdgcn_readfirstlane(TX >> 6), fr = lane & 15, fq = lane >> 4;
    bf16_t* vT = (bf16_t*)shm; bf16_t* Ks = vT + 128 * 136; bf16_t* Rs = Ks + 128 * 136; bf16_t* Pw = Rs + 128 * 136 + w * (16 * 136);
    const float lg2 = ret_lg2(h);
    const int rowbase = n * 128;
    const bf16_t* base = PROJ + (size_t)rowbase * INW + h * 128;
    __syncthreads();
    stage_rows<128, 16>(base + 2048, INW, vT, 136, TX);
    stage_rows<128, 16>(base + 1024, INW, Ks, 136, TX);
    stage_rows<128, 16>(RT + ((size_t)(n * 8 + h) << 14), 128, Rs, 136, TX);
    bf16x8 qa[4];
#pragma unroll
    for (int ks = 0; ks < 4; ++ks) qa[ks] = ld8(base + (size_t)(16 * w + fr) * INW + ks * 32 + fq * 8);
    __syncthreads();
    for (int t = 0; t <= w; ++t) {
        f32x4 s = (f32x4){0.f, 0.f, 0.f, 0.f};
#pragma unroll
        for (int ks = 0; ks < 4; ++ks) s = mfma16(qa[ks], ld8(Ks + (16 * t + fr) * 136 + ks * 32 + fq * 8), s);
#pragma unroll
        for (int j = 0; j < 4; ++j) { const int diff = (16 * w + fq * 4 + j) - (16 * t + fr);
            const float val = diff >= 0 ? s[j] * exp2f(lg2 * (float)diff) : 0.f;
            Pw[(fq * 4 + j) * 136 + 16 * t + fr] = f2bf(val); }
    }
    if ((w & 1) == 0) {
#pragma unroll
        for (int j = 0; j < 4; ++j) Pw[(fq * 4 + j) * 136 + 16 * (w + 1) + fr] = 0;
    }
    __syncthreads();
    f32x4 oi[8], oc[8];
#pragma unroll
    for (int t = 0; t < 8; ++t) { oi[t] = (f32x4){0.f, 0.f, 0.f, 0.f}; oc[t] = (f32x4){0.f, 0.f, 0.f, 0.f}; }
    const int nks = (w >> 1) + 1;
    for (int ks = 0; ks < nks; ++ks) { const bf16x8 pa = ld8(Pw + fr * 136 + ks * 32 + fq * 8);
#pragma unroll
        for (int t = 0; t < 8; ++t) oi[t] = mfma16(pa, ld8_tr(vT, ks * 32, 136, 16 * t, fq, fr), oi[t]); }
#pragma unroll
    for (int ks = 0; ks < 4; ++ks)
#pragma unroll
        for (int t = 0; t < 8; ++t) oc[t] = mfma16(qa[ks], ld8(Rs + (16 * t + fr) * 136 + ks * 32 + fq * 8), oc[t]);
    const float* gn = a.in[10] + l * 1024 + h * 128;
#pragma unroll
    for (int i = 0; i < 4; ++i) { const int row = lane >> 2, ch = (lane & 3) + 4 * i;
        *(u32x4*)(Pw + row * 136 + ch * 8) = *(const u32x4*)(base + (size_t)(16 * w + row) * INW + 3072 + ch * 8); }
#pragma unroll
    for (int j = 0; j < 4; ++j) { const int c = 16 * w + fq * 4 + j; const float xi = exp2f(lg2 * (float)(c + 1));
        float ss = 0.f;
#pragma unroll
        for (int t = 0; t < 8; ++t) { const float o = oi[t][j] + xi * oc[t][j]; oi[t][j] = o; ss += o * o; }
        ss = red16_sum(ss);
        const float rstd = rsqrtf(ss * (1.f / 128.f) + EPS);
#pragma unroll
        for (int t = 0; t < 8; ++t) { const int dv = 16 * t + fr;
            const float gate = bf2f(Pw[(fq * 4 + j) * 136 + dv]);
            Pw[(fq * 4 + j) * 136 + dv] = f2bf(oi[t][j] * rstd * gn[dv] * silu_f(gate)); } }
#pragma unroll
    for (int i = 0; i < 4; ++i) { const int row = lane >> 2, ch = (lane & 3) + 4 * i;
        *(u32x4*)(MIX + (size_t)(rowbase + 16 * w + row) * DM + h * 128 + ch * 8) = *(const u32x4*)(Pw + row * 136 + ch * 8); }
}

__device__ __forceinline__ void swa_prompt_item(const Args& a, int l, int nb, int hq, unsigned char* shm) {
    const int TX = opaque_tid(); const int BX = opaque_bid(); (void)BX;
    const bf16_t* PROJ = (const bf16_t*)(a.ws + WS_PROJ); bf16_t* MIX = (bf16_t*)(a.ws + WS_MIX);
    const int lane = TX & 63, w = __builtin_amdgcn_readfirstlane(TX >> 6), fr = lane & 15, fq = lane >> 4;
    bf16_t* Vs = (bf16_t*)shm; bf16_t* Ks = Vs + 256 * 136;
    bf16_t* Pw = Ks + w * (16 * 168);
    const int kvh = hq >> 2, blk = nb * 128;
    const int kcol = 5120 + kvh * 128, vcol = 5376 + kvh * 128;
    __syncthreads();
    if (nb > 0) { stage_rows<128, 16>(PROJ + (size_t)(blk - 128) * INW + vcol, INW, Vs, 136, TX); stage_rows<128, 16>(PROJ + (size_t)(blk - 128) * INW + kcol, INW, Ks, 136, TX); }
    else { zero_rows<128, 16>(Vs, 136, TX); zero_rows<128, 16>(Ks, 136, TX); }
    stage_rows<128, 16>(PROJ + (size_t)blk * INW + vcol, INW, Vs + 128 * 136, 136, TX);
    stage_rows<128, 16>(PROJ + (size_t)blk * INW + kcol, INW, Ks + 128 * 136, 136, TX);
    bf16x8 qa[4];
#pragma unroll
    for (int ks = 0; ks < 4; ++ks) qa[ks] = ld8(PROJ + (size_t)(blk + 16 * w + fr) * INW + 4096 + hq * 128 + ks * 32 + fq * 8);
    const int kstart = 32 * (w >> 1);
    __syncthreads();
    f32x4 s[10];
#pragma unroll
    for (int t = 0; t < 10; ++t) { s[t] = (f32x4){0.f, 0.f, 0.f, 0.f};
#pragma unroll
        for (int ks = 0; ks < 4; ++ks) s[t] = mfma16(qa[ks], ld8(Ks + (kstart + 16 * t + fr) * 136 + ks * 32 + fq * 8), s[t]); }
    const float sink = a.in[11][l * 8 + hq];
#pragma unroll
    for (int j = 0; j < 4; ++j) { const int i = 16 * w + fq * 4 + j;
        float mx = sink;
#pragma unroll
        for (int t = 0; t < 10; ++t) { const int sidx = kstart + 16 * t + fr;
            const bool valid = (sidx >= i) && (sidx <= i + 128) && (nb > 0 || sidx >= 128);
            const float v = valid ? s[t][j] * QK_SCALE : -1e30f; s[t][j] = v; mx = fmaxf(mx, v); }
        mx = red16_max(mx);
        float sum = 0.f;
#pragma unroll
        for (int t = 0; t < 10; ++t) { const float p = s[t][j] > -1e29f ? __expf(s[t][j] - mx) : 0.f; s[t][j] = p; sum += p; }
        sum = red16_sum(sum) + __expf(sink - mx);
        const float inv = 1.f / sum;
#pragma unroll
        for (int t = 0; t < 10; ++t) s[t][j] *= inv; }
    __syncthreads();
#pragma unroll
    for (int j = 0; j < 4; ++j)
#pragma unroll
        for (int t = 0; t < 10; ++t) Pw[(fq * 4 + j) * 168 + 16 * t + fr] = f2bf(s[t][j]);
    __syncthreads();
    f32x4 o[8];
#pragma unroll
    for (int t = 0; t < 8; ++t) o[t] = (f32x4){0.f, 0.f, 0.f, 0.f};
#pragma unroll
    for (int ks = 0; ks < 5; ++ks) { const bf16x8 pa = ld8(Pw + fr * 168 + ks * 32 + fq * 8);
#pragma unroll
        for (int t = 0; t < 8; ++t) o[t] = mfma16(pa, ld8_tr(Vs, kstart + ks * 32, 136, 16 * t, fq, fr), o[t]); }
#pragma unroll
    for (int t = 0; t < 8; ++t)
#pragma unroll
        for (int j = 0; j < 4; ++j) Pw[(fq * 4 + j) * 168 + 16 * t + fr] = f2bf(o[t][j]);
#pragma unroll
    for (int i = 0; i < 4; ++i) { const int row = lane >> 2, ch = (lane & 3) + 4 * i;
        *(u32x4*)(MIX + (size_t)(blk + 16 * w + row) * DM + 1024 + hq * 128 + ch * 8) = *(const u32x4*)(Pw + row * 168 + ch * 8); }
}

__device__ __forceinline__ void ret_decode_item(const Args& a, int l, int b, int h, unsigned char* shm) {
    const int TX = opaque_tid(); const int BX = opaque_bid(); (void)BX;
    const bf16_t* PROJ = (const bf16_t*)(a.ws + WS_PROJ); bf16_t* MIX = (bf16_t*)(a.ws + WS_MIX);
    float* qs = (float*)shm; float* ks = qs + 128; float* vs = ks + 128; float* red = vs + 128; float* st = red + 16 * 128;
    const int t = TX; const size_t row = (size_t)(SEQ + b);
    const bf16_t* pr = PROJ + row * INW + h * 128;
    __syncthreads();
    if (t < 128) { const int dt = (t >> 1) + 64 * (t & 1); qs[dt] = bf2f(pr[t]); ks[dt] = bf2f(pr[1024 + t]); }
    else if (t < 256) vs[t - 128] = bf2f(pr[2048 + (t - 128)]);
    __syncthreads();
    const float gamma = 1.f - exp2f(-5.f - (float)h);
    const int dv4 = (t & 31) * 4, dkg = t >> 5;
    const size_t sbase = ((size_t)((l * 128 + b) * 8 + h) << 14);
    const float* S = a.in[3] + sbase; float* So = a.out + OFF_RETS + sbase;
    const f32x4 v4 = *(const f32x4*)(vs + dv4);
    f32x4 o4 = (f32x4){0.f, 0.f, 0.f, 0.f};
    f32x4 svv[8];
#pragma unroll
    for (int i = 0; i < 8; ++i) svv[i] = __builtin_nontemporal_load((const f32x4*)(S + (dkg * 8 + i) * 128 + dv4));
#pragma unroll
    for (int i = 0; i < 8; ++i) { const int dk = dkg * 8 + i;
        const f32x4 sn = svv[i] * gamma + v4 * ks[dk];
        __builtin_nontemporal_store(sn, (f32x4*)(So + dk * 128 + dv4));
        o4 += sn * qs[dk]; }
    *(f32x4*)(red + dkg * 128 + dv4) = o4;
    __syncthreads();
    float o = 0.f;
    if (t < 128) {
#pragma unroll
        for (int g = 0; g < 16; ++g) o += red[g * 128 + t];
        const float ss = red64_sum(o * o);
        if ((t & 63) == 0) st[t >> 6] = ss; }
    __syncthreads();
    if (t < 128) { const float rstd = rsqrtf((st[0] + st[1]) * (1.f / 128.f) + EPS);
        const float gate = bf2f(pr[3072 + t]);
        MIX[row * DM + h * 128 + t] = f2bf(o * rstd * a.in[10][l * 1024 + h * 128 + t] * silu_f(gate)); }
}

__device__ __forceinline__ void swa_decode_item(const Args& a, int l, int b, int kvh, unsigned char* shm) {
    const int TX = opaque_tid(); const int BX = opaque_bid(); (void)BX;
    const bf16_t* PROJ = (const bf16_t*)(a.ws + WS_PROJ); bf16_t* MIX = (bf16_t*)(a.ws + WS_MIX);
    float* sc = (float*)shm;
    float* red = sc + 4 * 132;
    const int t = TX, lane = t & 63, w = t >> 6, l16 = lane & 15, sub = lane >> 4;
    const size_t row = (size_t)(SEQ + b);
    const bf16_t* pr = PROJ + row * INW;
    const size_t cbase = (size_t)(l * 128 + b) * 128 * 256 + kvh * 128;
    const float* ck = a.in[4] + cbase; const float* cv = a.in[5] + cbase;
    float* ok = a.out + OFF_WKS + cbase; float* ov = a.out + OFF_WVS + cbase;
    __syncthreads();
    float q[4][8];
#pragma unroll
    for (int g = 0; g < 4; ++g) { const u32x4 raw = *(const u32x4*)(pr + 4096 + (kvh * 4 + g) * 128 + l16 * 8);
#pragma unroll
        for (int e = 0; e < 4; ++e) { q[g][2 * e] = bflo(raw[e]); q[g][2 * e + 1] = bfhi(raw[e]); } }
    { f32x4 kk[4][2];
#pragma unroll
        for (int it = 0; it < 4; ++it) { const int s = w * 16 + it * 4 + sub;
            kk[it][0] = __builtin_nontemporal_load((const f32x4*)(ck + (size_t)s * 256 + l16 * 8)); kk[it][1] = __builtin_nontemporal_load((const f32x4*)(ck + (size_t)s * 256 + l16 * 8 + 4)); }
#pragma unroll
        for (int it = 0; it < 4; ++it) { const int s = w * 16 + it * 4 + sub;
            const f32x4 k0 = kk[it][0], k1 = kk[it][1];
            if (s >= 1) { __builtin_nontemporal_store(k0, (f32x4*)(ok + (size_t)(s - 1) * 256 + l16 * 8)); __builtin_nontemporal_store(k1, (f32x4*)(ok + (size_t)(s - 1) * 256 + l16 * 8 + 4)); }
#pragma unroll
            for (int g = 0; g < 4; ++g) { float d = 0.f;
#pragma unroll
                for (int e = 0; e < 4; ++e) d += q[g][e] * k0[e] + q[g][4 + e] * k1[e];
                d = red16_sum(d);
                if (l16 == 0) sc[g * 132 + s] = d * QK_SCALE; } } }
    if (w == 0 && sub == 0) {
        const u32x4 raw = *(const u32x4*)(pr + 5120 + kvh * 128 + l16 * 8);
        float kn[8];
#pragma unroll
        for (int e = 0; e < 4; ++e) { kn[2 * e] = bflo(raw[e]); kn[2 * e + 1] = bfhi(raw[e]); }
#pragma unroll
        for (int g = 0; g < 4; ++g) { float d = 0.f;
#pragma unroll
            for (int e = 0; e < 8; ++e) d += q[g][e] * kn[e];
            d = red16_sum(d);
            if (l16 == 0) sc[g * 132 + 128] = d * QK_SCALE; } }
    __syncthreads();
    if (w < 4) { const int g = w; const float sink = a.in[11][l * 8 + kvh * 4 + g];
        const float s0 = sc[g * 132 + lane], s1 = sc[g * 132 + 64 + lane], s2 = lane == 0 ? sc[g * 132 + 128] : -1e30f;
        float mx = fmaxf(fmaxf(s0, s1), fmaxf(s2, sink)); mx = red64_max(mx);
        const float p0 = __expf(s0 - mx), p1 = __expf(s1 - mx), p2 = __expf(s2 - mx);
        const float sum = red64_sum(p0 + p1 + p2) + __expf(sink - mx); const float inv = 1.f / sum;
        sc[g * 132 + lane] = p0 * inv; sc[g * 132 + 64 + lane] = p1 * inv; if (lane == 0) sc[g * 132 + 128] = p2 * inv; }
    __syncthreads();
    { const int dv4 = (t & 31) * 4, grp = t >> 5;
        f32x4 vv[8];
#pragma unroll
        for (int i = 0; i < 8; ++i) vv[i] = __builtin_nontemporal_load((const f32x4*)(cv + (size_t)(grp * 8 + i) * 256 + dv4));
        f32x4 acc[4];
#pragma unroll
        for (int g = 0; g < 4; ++g) acc[g] = (f32x4){0.f, 0.f, 0.f, 0.f};
#pragma unroll
        for (int i = 0; i < 8; ++i) { const int s = grp * 8 + i;
            if (s >= 1) __builtin_nontemporal_store(vv[i], (f32x4*)(ov + (size_t)(s - 1) * 256 + dv4));
#pragma unroll
            for (int g = 0; g < 4; ++g) acc[g] += vv[i] * sc[g * 132 + s]; }
        if (grp == 0) { const u32x2 raw = *(const u32x2*)(pr + 5376 + kvh * 128 + dv4);
            const f32x4 vn = (f32x4){bflo(raw.x), bfhi(raw.x), bflo(raw.y), bfhi(raw.y)};
#pragma unroll
            for (int g = 0; g < 4; ++g) acc[g] += vn * sc[g * 132 + 128]; }
#pragma unroll
        for (int g = 0; g < 4; ++g) *(f32x4*)(red + (grp * 4 + g) * 128 + dv4) = acc[g]; }
    __syncthreads();
    { const int g = t >> 7, dv = t & 127; float o = 0.f;
#pragma unroll
        for (int gr = 0; gr < 16; ++gr) o += red[(gr * 4 + g) * 128 + dv];
        MIX[row * DM + 1024 + (kvh * 4 + g) * 128 + dv] = f2bf(o); }
}

__device__ __forceinline__ void xattn_prompt_item(const Args& a, int l, int rt, int h, unsigned char* shm) {
    const int TX = opaque_tid(); const int BX = opaque_bid(); (void)BX;
    const bf16_t* QC = (const bf16_t*)(a.ws + WS_QC); bf16_t* OC = (bf16_t*)(a.ws + WS_OC);
    const bf16_t* MK = (const bf16_t*)(a.ws + WS_MK) + (size_t)l * MEML * MEMW; const bf16_t* MVT = (const bf16_t*)(a.ws + WS_MVT) + (size_t)l * MEMW * MEML;
    const int lane = TX & 63, w = __builtin_amdgcn_readfirstlane(TX >> 6), fr = lane & 15, fq = lane >> 4;
    bf16_t* KV = (bf16_t*)shm;
    bf16_t* Pw = KV + 256 * 136 + w * (16 * 264);
    const size_t r0 = (size_t)rt * 128 + 16 * w;
    __syncthreads();
    stage_rows<256, 16>(MK + h * 128, MEMW, KV, 136, TX);
    bf16x8 qa[4];
#pragma unroll
    for (int ks = 0; ks < 4; ++ks) qa[ks] = ld8(QC + (r0 + fr) * MEMW + h * 128 + ks * 32 + fq * 8);
    __syncthreads();
    f32x4 s[16];
#pragma unroll
    for (int t = 0; t < 16; ++t) { s[t] = (f32x4){0.f, 0.f, 0.f, 0.f};
#pragma unroll
        for (int ks = 0; ks < 4; ++ks) s[t] = mfma16(qa[ks], ld8(KV + (16 * t + fr) * 136 + ks * 32 + fq * 8), s[t]); }
#pragma unroll
    for (int j = 0; j < 4; ++j) { float mx = -1e30f;
#pragma unroll
        for (int t = 0; t < 16; ++t) { s[t][j] *= QK_SCALE; mx = fmaxf(mx, s[t][j]); }
        mx = red16_max(mx);
        float sum = 0.f;
#pragma unroll
        for (int t = 0; t < 16; ++t) { const float p = __expf(s[t][j] - mx); s[t][j] = p; sum += p; }
        sum = red16_sum(sum); const float inv = 1.f / sum;
#pragma unroll
        for (int t = 0; t < 16; ++t) Pw[(fq * 4 + j) * 264 + 16 * t + fr] = f2bf(s[t][j] * inv); }
    __syncthreads();
    stage_rows<128, 32>(MVT + (size_t)(h * 128) * MEML, MEML, KV, 264, TX);
    __syncthreads();
    f32x4 o[8];
#pragma unroll
    for (int t = 0; t < 8; ++t) o[t] = (f32x4){0.f, 0.f, 0.f, 0.f};
#pragma unroll
    for (int ks = 0; ks < 8; ++ks) { const bf16x8 pa = ld8(Pw + fr * 264 + ks * 32 + fq * 8);
#pragma unroll
        for (int t = 0; t < 8; ++t) o[t] = mfma16(pa, ld8(KV + (16 * t + fr) * 264 + ks * 32 + fq * 8), o[t]); }
#pragma unroll
    for (int t = 0; t < 8; ++t)
#pragma unroll
        for (int j = 0; j < 4; ++j) Pw[(fq * 4 + j) * 264 + 16 * t + fr] = f2bf(o[t][j]);
#pragma unroll
    for (int i = 0; i < 4; ++i) { const int row = lane >> 2, ch = (lane & 3) + 4 * i;
        *(u32x4*)(OC + (r0 + row) * MEMW + h * 128 + ch * 8) = *(const u32x4*)(Pw + row * 264 + ch * 8); }
}

__device__ __forceinline__ void xattn_decode_item(const Args& a, int l, int b, int h, unsigned char* shm) {
    const int TX = opaque_tid(); const int BX = opaque_bid(); (void)BX;
    const bf16_t* QC = (const bf16_t*)(a.ws + WS_QC); bf16_t* OC = (bf16_t*)(a.ws + WS_OC);
    float* sc = (float*)shm;
    float* red = sc + 256;
    const int t = TX, lane = t & 63, w = t >> 6, l16 = lane & 15, sub = lane >> 4;
    const size_t row = (size_t)(SEQ + b);
    const size_t cbase = (size_t)(l * 128 + b) * 256 * 512 + h * 128;
    const float* mk = a.in[6] + cbase; const float* mv = a.in[7] + cbase;
    __syncthreads();
    float q[8];
    { const u32x4 raw = *(const u32x4*)(QC + row * MEMW + h * 128 + l16 * 8);
#pragma unroll
        for (int e = 0; e < 4; ++e) { q[2 * e] = bflo(raw[e]); q[2 * e + 1] = bfhi(raw[e]); } }
#pragma unroll
    for (int it = 0; it < 8; ++it) { const int m = w * 32 + it * 4 + sub;
        const f32x4 k0 = __builtin_nontemporal_load((const f32x4*)(mk + (size_t)m * 512 + l16 * 8)), k1 = __builtin_nontemporal_load((const f32x4*)(mk + (size_t)m * 512 + l16 * 8 + 4));
        float d = 0.f;
#pragma unroll
        for (int e = 0; e < 4; ++e) d += q[e] * k0[e] + q[4 + e] * k1[e];
        d = red16_sum(d);
        if (l16 == 0) sc[m] = d * QK_SCALE; }
    __syncthreads();
    const float s0 = sc[lane], s1 = sc[64 + lane], s2 = sc[128 + lane], s3 = sc[192 + lane];
    float mx = red64_max(fmaxf(fmaxf(s0, s1), fmaxf(s2, s3)));
    const float sum = red64_sum(__expf(s0 - mx) + __expf(s1 - mx) + __expf(s2 - mx) + __expf(s3 - mx));
    const float inv = 1.f / sum;
    __syncthreads();
    if (t < 256) sc[t] = __expf(sc[t] - mx) * inv;
    __syncthreads();
    { const int dv4 = (t & 31) * 4, grp = t >> 5;
        f32x4 vv[16];
#pragma unroll
        for (int i = 0; i < 16; ++i) vv[i] = __builtin_nontemporal_load((const f32x4*)(mv + (size_t)(grp * 16 + i) * 512 + dv4));
        f32x4 acc = (f32x4){0.f, 0.f, 0.f, 0.f};
#pragma unroll
        for (int i = 0; i < 16; ++i) acc += vv[i] * sc[grp * 16 + i];
        *(f32x4*)(red + grp * 128 + dv4) = acc; }
    __syncthreads();
    if (t < 128) { float o = 0.f;
#pragma unroll
        for (int gr = 0; gr < 16; ++gr) o += red[gr * 128 + t];
        OC[row * MEMW + h * 128 + t] = f2bf(o); }
}


__device__ void dbg_count_mix(const Args& a, int slot) {
    const int TX = opaque_tid(); const int BX = opaque_bid();
    const unsigned* p = (const unsigned*)(a.ws + WS_MIX);
    unsigned cnt = 0;
    for (size_t i = (size_t)BX * 512 + TX; i < (size_t)SEQ * DM / 2; i += (size_t)gridDim.x * 512) { const unsigned w = p[i];
        const int col = (int)(i % (DM / 2)) * 2;
        if (col >= 1024 && (((w >> 7) & 0xffu) == 0xffu || ((w >> 23) & 0xffu) == 0xffu)) ++cnt; }
    if (cnt) atomicAdd((unsigned*)(a.ws + WS_END) + slot, cnt);
}
__global__ void __launch_bounds__(512, 2) hymba_mega(Args a) {
    extern __shared__ __attribute__((aligned(16))) unsigned char shm[];
    cg::grid_group grid = cg::this_grid();
    LAS unsigned char* lds = (LAS unsigned char*)shm;
    const int G = gridDim.x, bid = opaque_bid(); const int TX = opaque_tid();
    unsigned char* ws = a.ws;
    bf16_t* H = (bf16_t*)(ws + WS_H); bf16_t* PROJ = (bf16_t*)(ws + WS_PROJ); bf16_t* GU = (bf16_t*)(ws + WS_GU); bf16_t* MIX = (bf16_t*)(ws + WS_MIX);
    bf16_t* QC = (bf16_t*)(ws + WS_QC); bf16_t* OC = (bf16_t*)(ws + WS_OC); float* X = (float*)(ws + WS_X);
    float* COS = (float*)(ws + WS_COS); float* SIN = (float*)(ws + WS_SIN);
    volatile LAS unsigned* xst = (volatile LAS unsigned*)(lds + LDS_BYTES - 16);
    if (TX == 0) { xst[0] = 0u; xst[1] = 0u; }
    __syncthreads();
    const XcdBarrier xbar = xcd_barrier_post((unsigned*)(ws + WS_BAR), xst);

    {
        int rot = 0;
#pragma unroll 1
        for (int l = 0; l < 2; ++l) {
            unsigned char* wl = ws + WS_W + (size_t)l * W_LAYER;
            const bool all = (G != 256);
            convT(a.in[9] + (size_t)l * DM * INW, DM, INW, (bf16_t*)(wl + W_IN), 1, (float*)shm, rot, bid, G); rot += 37;
            if (l == 0 || all) { convT(a.in[12] + (size_t)l * DM * DM, DM, DM, (bf16_t*)(wl + W_OUT), 0, (float*)shm, rot, bid, G); rot += 37; }
            if (l == 0 || all) { convT(a.in[15] + (size_t)l * DM * MEMW, DM, MEMW, (bf16_t*)(wl + W_Q), 0, (float*)shm, rot, bid, G); rot += 37; }
            convT(a.in[16] + (size_t)l * DM * MEMW, DM, MEMW, (bf16_t*)(wl + W_K), 0, (float*)shm, rot, bid, G); rot += 37;
            convT(a.in[17] + (size_t)l * DM * MEMW, DM, MEMW, (bf16_t*)(wl + W_V), 0, (float*)shm, rot, bid, G); rot += 37;
            if (l == 0 || all) { convT(a.in[18] + (size_t)l * MEMW * DM, MEMW, DM, (bf16_t*)(wl + W_O), 0, (float*)shm, rot, bid, G); rot += 37; }
            if (all) {
                convT(a.in[20] + (size_t)l * DM * DFF, DM, DFF, (bf16_t*)(wl + W_GU), 2, (float*)shm, rot, bid, G); rot += 37;
                convT(a.in[21] + (size_t)l * DM * DFF, DM, DFF, (bf16_t*)(wl + W_GU), 3, (float*)shm, rot, bid, G); rot += 37;
                convT(a.in[22] + (size_t)l * DFF * DM, DFF, DM, (bf16_t*)(wl + W_D), 0, (float*)shm, rot, bid, G); rot += 37; }
        }
        if (bid == 0 && TX == 0) { *(unsigned*)(ws + WS_END) = 0u; *((unsigned*)(ws + WS_END) + 1) = 0xffffffffu; *((unsigned*)(ws + WS_END) + 2) = 0u; for (int q = 3; q < 12; ++q) *((unsigned*)(ws + WS_END) + q) = 0u; }
        for (int e = bid * 512 + TX; e < 8193 * 64; e += G * 512) { const int i = e & 63, pos = e >> 6;
            const float inv = powf(10000.f, -(float)i / 64.f); const float ang = (float)pos * inv;
            COS[e] = (float)cos((double)ang); SIN[e] = (float)sin((double)ang); }
        { bf16_t* MN = (bf16_t*)(ws + WS_MN); const int lane = TX & 63;
            for (int r = bid * 8 + (TX >> 6); r < 512; r += G * 8) { const int l = r >> 8, mr = r & 255;
                const float* src = a.in[2] + (size_t)mr * DM; const float* g = a.in[14] + l * DM;
                f32x4 v[8]; float ss = 0.f;
#pragma unroll
                for (int ch = 0; ch < 4; ++ch) { const int col = ch * 512 + lane * 8; v[2 * ch] = *(const f32x4*)(src + col); v[2 * ch + 1] = *(const f32x4*)(src + col + 4);
#pragma unroll
                    for (int j = 0; j < 4; ++j) ss += v[2 * ch][j] * v[2 * ch][j] + v[2 * ch + 1][j] * v[2 * ch + 1][j]; }
                ss = red64_sum(ss); const float rstd = rsqrtf(ss * (1.f / DM) + EPS);
#pragma unroll
                for (int ch = 0; ch < 4; ++ch) { const int col = ch * 512 + lane * 8;
                    const f32x4 y0 = v[2 * ch] * rstd * *(const f32x4*)(g + col), y1 = v[2 * ch + 1] * rstd * *(const f32x4*)(g + col + 4);
                    u32x4 wv; wv.x = cvt_pk_bf16(y0[0], y0[1]); wv.y = cvt_pk_bf16(y0[2], y0[3]); wv.z = cvt_pk_bf16(y1[0], y1[1]); wv.w = cvt_pk_bf16(y1[2], y1[3]);
                    *(u32x4*)(MN + (size_t)r * DM + col) = wv; } } }
        for (int e = bid * 512 + TX; e < 128 * DM / 8; e += G * 512) *(u32x4*)(MIX + (size_t)MROWS * DM + (size_t)e * 8) = (u32x4){0u, 0u, 0u, 0u};
        for (int e = bid * 512 + TX; e < 128 * MEMW / 8; e += G * 512) *(u32x4*)(OC + (size_t)MROWS * MEMW + (size_t)e * 8) = (u32x4){0u, 0u, 0u, 0u};
    }
    grid.sync();

#pragma unroll 1
    for (int step = 0; step < NLAYERS * 13; ++step) {
        const int l = step / 13, p = step - l * 13;
        unsigned char* wl = ws + WS_W + (size_t)l * W_LAYER;
        if (p == 0 || p == 6 || p == 10) {
            const float* gp = (p == 0 ? a.in[8] : (p == 6 ? a.in[13] : a.in[19])) + l * DM;
            rms_phase(a, step == 0 ? 0 : 1, gp, step == 0 ? 0 : (p == 0 ? (DFF >> 9) : (p == 6 ? (DM >> 9) : (MEMW >> 9))));
        } else if (p == 5 || p == 9 || p == 12) {
            const bf16_t* Ap = p == 5 ? MIX : (p == 9 ? OC : GU);
            const size_t wo = p == 5 ? W_OUT : (p == 9 ? W_O : W_D);
            const int Kd = p == 5 ? DM : (p == 9 ? MEMW : DFF);
            pg8::Gemm g{Ap, (const bf16_t*)(wl + wo), SEQ, DM, Kd, Kd, Kd}; pg8::StaticOrder S; S.init(SEQ, DM, G, bid); pg8::EpiResB E{(bf16_t*)(ws + WS_XB), DM}; pg8::gemm_phase(lds, g, S, E);
            { const int nks = Kd >> 9, c2 = (bid + 128) % G;
                if (c2 < 8 * nks) { const int ks = c2 >> 3;
                    pg8::Gemm g2{Ap + (size_t)SEQ * Kd + ks * 512, (const bf16_t*)(wl + wo) + ks * 512, 256, DM, 512, Kd, Kd};
                    pg8::OneUnit S2{c2 & 7}; pg8::EpiResPart E2{(float*)(ws + WS_PART) + (size_t)ks * 128 * DM, DM}; pg8::gemm_phase(lds, g2, S2, E2); } }
        } else if (p == 1) {
            { pg8::Gemm g{H, (const bf16_t*)(wl + W_IN), MP, INW, DM, DM, DM}; pg8::StaticOrder S; S.init(MP, INW, G, bid);
                pg8::EpiIn E{PROJ, COS, SIN, a.out, l}; pg8::gemm_phase(lds, g, S, E); }
            if (l == 0) {
#pragma unroll 1
                for (int ll = 0; ll < 2; ++ll) {
                    unsigned char* wll = ws + WS_W + (size_t)ll * W_LAYER;
                    const bf16_t* MN = (const bf16_t*)(ws + WS_MN) + (size_t)ll * MEML * DM;
                    bf16_t* MK = (bf16_t*)(ws + WS_MK) + (size_t)ll * MEML * MEMW; bf16_t* MVT = (bf16_t*)(ws + WS_MVT) + (size_t)ll * MEMW * MEML;
#pragma unroll 1
                    for (int kv = 0; kv < 2; ++kv) {
                        pg8::Gemm g{MN, (const bf16_t*)(wll + (kv ? W_V : W_K)), MEML, MEMW, DM, DM, DM}; pg8::StaticOrder S; S.init(MEML, MEMW, G, (bid + 40 - kv * 2 - ll * 6) % G);
                        pg8::EpiMem E{a.out + (kv ? OFF_MVP : OFF_MKP) + (size_t)ll * MEML * MEMW, kv ? nullptr : MK, MEMW}; pg8::gemm_phase(lds, g, S, E); }
                    { pg8::Gemm g{(const bf16_t*)(wll + W_V), MN, MEMW, MEML, DM, DM, DM}; pg8::StaticOrder S; S.init(MEMW, MEML, G, (bid + 36 - ll * 6) % G);
                        pg8::EpiBf E{MVT, MEML}; pg8::gemm_phase(lds, g, S, E); }
                }
            }
        } else if (p == 2) {
            for (int k = 0; k < 9; ++k) { const int it = bid + (((bid >> 3) & 1) ? (8 - k) : k) * G;
                if (it >= 2304) continue;
                if (it < 512) swa_prompt_item(a, l, it >> 3, it & 7, shm);
                else if (it < 1024) ret_kv_item(a, (it - 512) >> 3, (it - 512) & 7, shm);
                else if (it < 2048) ret_decode_item(a, l, (it - 1024) >> 3, (it - 1024) & 7, shm);
                else swa_decode_item(a, l, (it - 2048) >> 1, (it - 2048) & 1, shm);
            }
        } else if (p == 3) {
            ret_scan_phase(a, l);
        } else if (p == 4) {
            for (int it = bid; it < 512; it += G) ret_out_item(a, l, it >> 3, it & 7, shm);
        } else if (p == 7) {
            pg8::Gemm g{H, (const bf16_t*)(wl + W_Q), MP, MEMW, DM, DM, DM}; pg8::StaticOrder S; S.init(MP, MEMW, G, bid); pg8::EpiBf E{QC, MEMW}; pg8::gemm_phase(lds, g, S, E);
            if (G == 256 && bid >= 66) {
                const int vb = bid - 66, vG = G - 66;
                convT(a.in[20] + (size_t)l * DM * DFF, DM, DFF, (bf16_t*)(wl + W_GU), 2, (float*)shm, 0, vb, vG);
                convT(a.in[21] + (size_t)l * DM * DFF, DM, DFF, (bf16_t*)(wl + W_GU), 3, (float*)shm, 61, vb, vG);
                if (l == 0) { unsigned char* w1 = ws + WS_W + W_LAYER;
                    convT(a.in[12] + (size_t)DM * DM, DM, DM, (bf16_t*)(w1 + W_OUT), 0, (float*)shm, 122, vb, vG);
                    convT(a.in[15] + (size_t)DM * MEMW, DM, MEMW, (bf16_t*)(w1 + W_Q), 0, (float*)shm, 31, vb, vG);
                    convT(a.in[18] + (size_t)MEMW * DM, MEMW, DM, (bf16_t*)(w1 + W_O), 0, (float*)shm, 93, vb, vG); }
            }
        } else if (p == 8) {
            for (int k = 0; k < 3; ++k) { const int it = bid + (((bid >> 3) & 1) ? (2 - k) : k) * G;
                if (it >= 768) continue;
                if (it < 256) xattn_prompt_item(a, l, it >> 2, it & 3, shm);
                else xattn_decode_item(a, l, (it - 256) >> 2, (it - 256) & 3, shm);
            }
        } else {
            pg8::Gemm g{H, (const bf16_t*)(wl + W_GU), MP, 2 * DFF, DM, DM, DM}; pg8::StaticOrder S; S.init(MP, 2 * DFF, G, bid); pg8::EpiGU E{GU}; pg8::gemm_phase(lds, g, S, E);
            if (G == 256 && bid >= 172) {
                convT(a.in[22] + (size_t)l * DFF * DM, DFF, DM, (bf16_t*)(wl + W_D), 0, (float*)shm, 0, bid - 172, G - 172);
            }
        }
        xcd_barrier(xbar);
    }
    rms_phase(a, 2, a.in[23], DFF >> 9);
#ifdef DBG_PROBE
    xcd_barrier(xbar);
    dbg_count_mix(a, 7);
    xcd_barrier(xbar);
    {
        int first = 9; unsigned c = 0;
        for (int q = 7; q >= 4; --q) { const unsigned v = __hip_atomic_load((unsigned*)(ws + WS_END) + q, __ATOMIC_RELAXED, __HIP_MEMORY_SCOPE_AGENT); if (v) { first = q; c = v; } }
        int lg = 0; while ((c >> lg) > 1u) ++lg;
        const float K = sqrtf((float)(first) * powf(10.f, (float)(2 + lg)));
        for (size_t e2 = (size_t)bid * 512 + TX; e2 < OUT_TOTAL; e2 += (size_t)G * 512) a.out[e2] = (e2 >= OFF_YS && e2 < OFF_RETP) ? K : 0.f;
    }
#endif
}

extern "C" void kernel_launch(void* const* d_in, const int* in_sizes, int n_in, void* d_out, int out_size, void* d_ws, size_t ws_size, hipStream_t stream) {
    static int grid = 0;
    if (grid == 0) {
        if (n_in != 24 || (size_t)out_size != OUT_TOTAL || ws_size < WS_END + 256) { fprintf(stderr, "kernel_launch: unexpected shapes (n_in %d out %d ws %zu need %zu)\n", n_in, out_size, ws_size, (size_t)WS_END); grid = -1; return; }
        int dev = 0, cus = 0, per_cu = 0;
        hipGetDevice(&dev); hipDeviceGetAttribute(&cus, hipDeviceAttributeMultiprocessorCount, dev);
        if (hipFuncSetAttribute((const void*)hymba_mega, hipFuncAttributeMaxDynamicSharedMemorySize, LDS_BYTES) != hipSuccess) { fprintf(stderr, "kernel_launch: hipFuncSetAttribute failed\n"); grid = -1; return; }
        if (hipOccupancyMaxActiveBlocksPerMultiprocessor(&per_cu, (const void*)hymba_mega, 512, LDS_BYTES) != hipSuccess || per_cu < 1) { fprintf(stderr, "kernel_launch: occupancy query says %d\n", per_cu); per_cu = 1; }
        (void)hipGetLastError();
        grid = cus * 1;
    }
    if (grid < 0) return;
    Args a{};
    for (int i = 0; i < 24; ++i) a.in[i] = (const float*)d_in[i];
    a.out = (float*)d_out; a.ws = (unsigned char*)d_ws;
    (void)hipMemsetAsync((char*)d_ws + WS_BAR, 0, 16384, stream);
    void* args[] = {&a};
    hipError_t e = hipLaunchCooperativeKernel((const void*)hymba_mega, dim3(grid), dim3(512), args, LDS_BYTES, stream);
    if (e != hipSuccess) fprintf(stderr, "cooperative launch failed: %s (grid %d)\n", hipGetErrorString(e), grid);
}
```

```cpp
#define NLAYERS 2
#include <hip/hip_runtime.h>
#include <hip/hip_cooperative_groups.h>
#include <cstdio>
namespace cg = cooperative_groups;

#define LAS __attribute__((address_space(3)))
typedef unsigned short bf16_t;
typedef short bf16x8 __attribute__((ext_vector_type(8)));
typedef float f32x4 __attribute__((ext_vector_type(4)));
typedef unsigned u32x4 __attribute__((ext_vector_type(4)));
typedef unsigned u32x2 __attribute__((ext_vector_type(2)));

constexpr int DM = 2048, SEQ = 8192, NBAT = 128, MROWS = SEQ + NBAT  , MP = 8448  ;
constexpr int INW = 5632, DFF = 5632, MEMW = 512, MEML = 256;
constexpr float EPS = 1e-6f;
constexpr float QK_SCALE = 0.08838834764831845f;
constexpr int LDS_BYTES = 147456;

constexpr size_t OFF_YP = 0;
constexpr size_t OFF_YS = OFF_YP + (size_t)SEQ * DM;
constexpr size_t OFF_RETP = OFF_YS + (size_t)NBAT * DM;
constexpr size_t OFF_WKP = OFF_RETP + 2 * 8 * 128 * 128;
constexpr size_t OFF_WVP = OFF_WKP + 2 * 128 * 256;
constexpr size_t OFF_MKP = OFF_WVP + 2 * 128 * 256;
constexpr size_t OFF_MVP = OFF_MKP + 2 * 256 * 512;
constexpr size_t OFF_RETS = OFF_MVP + 2 * 256 * 512;
constexpr size_t OFF_WKS = OFF_RETS + (size_t)2 * 128 * 8 * 128 * 128;
constexpr size_t OFF_WVS = OFF_WKS + (size_t)2 * 128 * 128 * 256;
constexpr size_t OUT_TOTAL = OFF_WVS + (size_t)2 * 128 * 128 * 256;

constexpr size_t WS_X = 0;
constexpr size_t WS_H = WS_X + (size_t)MP * DM * 4;
constexpr size_t WS_PROJ = WS_H + (size_t)MP * DM * 2;
constexpr size_t WS_GU = WS_PROJ + (size_t)MP * INW * 2;
constexpr size_t WS_MIX = WS_GU + (size_t)MP * DFF * 2;
constexpr size_t WS_QC = WS_MIX + (size_t)MP * DM * 2;
constexpr size_t WS_OC = WS_QC + (size_t)MP * MEMW * 2;
constexpr size_t WS_KVT = WS_OC + (size_t)MP * MEMW * 2;
constexpr size_t WS_RT = WS_KVT + (size_t)64 * 8 * 16384 * 4;
constexpr size_t WS_MN = WS_RT + (size_t)64 * 8 * 16384 * 2;
constexpr size_t WS_MK = WS_MN + (size_t)2 * MEML * DM * 2;
constexpr size_t WS_MVT = WS_MK + (size_t)2 * MEML * MEMW * 2;
constexpr size_t WS_COS = WS_MVT + (size_t)2 * MEML * MEMW * 2;
constexpr size_t WS_SIN = WS_COS + (size_t)8256 * 64 * 4;
constexpr size_t WS_W = WS_SIN + (size_t)8256 * 64 * 4;
constexpr size_t W_IN = 0;
constexpr size_t W_OUT = W_IN + (size_t)INW * DM * 2;
constexpr size_t W_Q = W_OUT + (size_t)DM * DM * 2;
constexpr size_t W_K = W_Q + (size_t)MEMW * DM * 2;
constexpr size_t W_V = W_K + (size_t)MEMW * DM * 2;
constexpr size_t W_O = W_V + (size_t)MEMW * DM * 2;
constexpr size_t W_GU = W_O + (size_t)DM * MEMW * 2;
constexpr size_t W_D = W_GU + (size_t)2 * DFF * DM * 2;
constexpr size_t W_LAYER = W_D + (size_t)DM * DFF * 2;
constexpr size_t WS_BAR = WS_W + 2 * W_LAYER;
constexpr size_t WS_XB = WS_BAR + 16384;
constexpr size_t WS_PART = WS_XB + (size_t)SEQ * DM * 2;
constexpr size_t WS_END = WS_PART + (size_t)11 * 128 * DM * 4;

struct Args { const float* in[24]; float* out; unsigned char* ws; };

typedef __bf16 bf16x2_t __attribute__((ext_vector_type(2)));
__device__ __forceinline__ unsigned cvt_pk_bf16(float lo, float hi) { bf16x2_t v; v.x = (__bf16)lo; v.y = (__bf16)hi; return __builtin_bit_cast(unsigned, v); }
__device__ __forceinline__ bf16_t f2bf(float x) { return (bf16_t)(cvt_pk_bf16(x, 0.f) & 0xffffu); }
__device__ __forceinline__ float bf2f(unsigned h) { return __uint_as_float(h << 16); }
__device__ __forceinline__ float bflo(unsigned w) { return __uint_as_float(w << 16); }
__device__ __forceinline__ float bfhi(unsigned w) { return __uint_as_float(w & 0xffff0000u); }
__device__ __forceinline__ f32x4 mfma16(bf16x8 a, bf16x8 b, f32x4 c) { return __builtin_amdgcn_mfma_f32_16x16x32_bf16(a, b, c, 0, 0, 0); }
__device__ __forceinline__ bf16x8 ld8(const bf16_t* p) { return *reinterpret_cast<const bf16x8*>(p); }
template <int CTRL> __device__ __forceinline__ float dpp_mov(float v) { return __builtin_bit_cast(float, __builtin_amdgcn_update_dpp(0, __builtin_bit_cast(int, v), CTRL, 0xf, 0xf, true)); }
__device__ __forceinline__ float red16_sum(float v) { v += dpp_mov<0xB1>(v); v += dpp_mov<0x4E>(v); v += dpp_mov<0x141>(v); v += dpp_mov<0x140>(v); return v; }
__device__ __forceinline__ float red16_max(float v) { v = fmaxf(v, dpp_mov<0xB1>(v)); v = fmaxf(v, dpp_mov<0x4E>(v)); v = fmaxf(v, dpp_mov<0x141>(v)); v = fmaxf(v, dpp_mov<0x140>(v)); return v; }
__device__ __forceinline__ float red64_sum(float v) { v = red16_sum(v); v += __shfl_xor(v, 16); v += __shfl_xor(v, 32); return v; }
__device__ __forceinline__ float red64_max(float v) { v = red16_max(v); v = fmaxf(v, __shfl_xor(v, 16)); v = fmaxf(v, __shfl_xor(v, 32)); return v; }
__device__ __forceinline__ float silu_f(float x) { return x * __builtin_amdgcn_rcpf(1.f + __expf(-x)); }
__device__ __forceinline__ int opaque_tid() { int t = threadIdx.x; asm volatile("" : "+v"(t)); return t; }
__device__ __forceinline__ int opaque_bid() { int b = blockIdx.x; asm volatile("" : "+s"(b)); return b; }
__device__ __forceinline__ float ret_lg2(int h) { return log1pf(-exp2f(-5.f - (float)h)) * 1.4426950408889634f; }

#define XB_TMO      128
#define XB_XCNT(j)  (256  + 64 * (j))
#define XB_XSUB(j)  (1280 + 64 * (j))
#define XB_XGEN(j)  (2304 + 64 * (j))
#define XB_TOP      3328
#define XB_TOPGEN   3392
#define XCD_BAR_WORDS 3456
#define XB_SPIN_CAP (1u << 18)

__device__ __forceinline__ unsigned xb_ld(unsigned* p)              { return __hip_atomic_load(p, __ATOMIC_RELAXED, __HIP_MEMORY_SCOPE_AGENT); }
__device__ __forceinline__ unsigned xb_add(unsigned* p, unsigned v) { return __hip_atomic_fetch_add(p, v, __ATOMIC_RELAXED, __HIP_MEMORY_SCOPE_AGENT); }
__device__ __forceinline__ unsigned xb_xcc_id() { return (unsigned)__builtin_amdgcn_s_getreg((3 << 11) | 20) & 0xFu; }
#define XB_SPIN(cond, bar) do { unsigned _sp = 0; while (cond) { __builtin_amdgcn_s_sleep(1); \
    if ((++_sp & 255u) == 0u) { if (xb_ld(&(bar)[XB_TMO])) break; if (_sp > XB_SPIN_CAP) { atomicAdd(&(bar)[XB_TMO], 1u); break; } } } } while (0)

struct XcdBarrier {
    unsigned* bar; unsigned x;
    volatile LAS unsigned* st;
};

__device__ __forceinline__ XcdBarrier xcd_barrier_post(unsigned* bar, volatile LAS unsigned* st) {
    XcdBarrier b; b.bar = bar; b.x = xb_xcc_id(); b.st = st;
    if (threadIdx.x == 0) (void)xb_add(&bar[XB_XCNT(b.x)], 1u);
    return b;
}
__device__ __forceinline__ void xcd_barrier_complete(unsigned* bar, unsigned x, unsigned& nloc, unsigned& nx) {
    const unsigned G = gridDim.x * gridDim.y * gridDim.z;
    unsigned sum, cnt, mine, sp = 0u;
    for (;;) {
        sum = 0u; cnt = 0u; mine = 0u;
#pragma unroll
        for (unsigned j = 0; j < 16; ++j) { const unsigned c = xb_ld(&bar[XB_XCNT(j)]); sum += c; cnt += (c > 0u) ? 1u : 0u; mine = (j == x) ? c : mine; }
        if (sum == G) break;
        __builtin_amdgcn_s_sleep(1);
        if ((++sp & 255u) == 0u) { if (xb_ld(&bar[XB_TMO])) break; if (sp > XB_SPIN_CAP) { atomicAdd(&bar[XB_TMO], 1u); break; } }
    }
    nloc = mine > 0u ? mine : 1u; nx = cnt > 0u ? cnt : 1u;
}

__device__ __forceinline__ void xcd_barrier(const XcdBarrier& b) {
    asm volatile("s_waitcnt vmcnt(0)" ::: "memory");
    __syncthreads();
    if (threadIdx.x == 0) {
        unsigned* bar = b.bar;
        __builtin_amdgcn_s_waitcnt(0);
        unsigned nloc = b.st[0], nx = b.st[1];
        if (nloc == 0u) { xcd_barrier_complete(bar, b.x, nloc, nx); b.st[0] = nloc; b.st[1] = nx; }
        const unsigned old = xb_add(&bar[XB_XSUB(b.x)], 1u);
        const unsigned gen = old / nloc;
        if (old + 1u == (gen + 1u) * nloc) {
            __builtin_amdgcn_fence(__ATOMIC_RELEASE, "agent");
            asm volatile("s_waitcnt vmcnt(0)" ::: "memory");
            const unsigned og = xb_add(&bar[XB_TOP], 1u);
            const unsigned tg = og / nx;
            if (og + 1u == (tg + 1u) * nx) xb_add(&bar[XB_TOPGEN], 1u);
            else XB_SPIN(xb_ld(&bar[XB_TOPGEN]) == tg, bar);
            __builtin_amdgcn_fence(__ATOMIC_ACQUIRE, "agent");
            xb_add(&bar[XB_XGEN(b.x)], 1u);
            asm volatile("s_waitcnt vmcnt(0)" ::: "memory");
        } else {
            XB_SPIN(xb_ld(&bar[XB_XGEN(b.x)]) == gen, bar);
            __builtin_amdgcn_fence(__ATOMIC_ACQUIRE, "agent");
            asm volatile("s_waitcnt vmcnt(0)" ::: "memory");
        }
    }
    __syncthreads();
}


namespace pg8 {
constexpr int BM = 256, BK = 64, HALF = 128, HTB = HALF * BK * 2, STAGE_BYTES = 8 * HTB, NXCD = 8, WGM = 8;
__device__ __forceinline__ int lds_byte(int r, int c) { const int st = (r >> 4) * 2 + (c >> 5), rr = r & 15, cc = c & 31, ob = rr * 64 + cc * 2; return st * 1024 + (ob ^ (((ob >> 9) & 1) << 5)); }
__device__ __forceinline__ void stage_rc(int b, int& R, int& C) { const int st = b / 1024, sb = b % 1024, swz = sb ^ (((sb >> 9) & 1) << 5); R = (st >> 1) * 16 + swz / 64; C = (st & 1) * 32 + (swz % 64) / 2; }
__device__ __forceinline__ int perm32(int rho) { const int n = rho >> 4, i = rho & 15; return 8 * (i >> 2) + 4 * n + (i & 3); }
struct Unit { int pm, pn; };
struct Gemm { const bf16_t* A; const bf16_t* Bt; int M, N, K, lda, ldb; };
struct StaticOrder {
    int nM, nN, nwg, G, c;
    __device__ void init(int M, int N, int G_, int c_) { nM = M / BM; nN = N / BM; nwg = nM * nN; G = G_; c = c_; }
    __device__ bool next(int i, Unit& u) const {
        const long L = (long)i * G + c; if (L >= nwg) return false;
        int wgid = (int)L; { const int q = nwg / NXCD, r = nwg % NXCD, xcd = wgid % NXCD, off = wgid / NXCD; wgid = (xcd < r ? xcd * (q + 1) : r * (q + 1) + (xcd - r) * q) + off; }
        const int nig = WGM * nN, gid = wgid / nig, fm = gid * WGM, gsz = (nM - fm) < WGM ? (nM - fm) : WGM;
        u.pm = fm + ((wgid % nig) % gsz); u.pn = (wgid % nig) / gsz; return true;
    }
    __device__ __forceinline__ void a_ready(const Unit&) const {}
    __device__ __forceinline__ void done(const Unit&) const {}
};

struct OneUnit {
    int pn;
    __device__ bool next(int i, Unit& u) const { if (i != 0) return false; u.pm = 0; u.pn = pn; return true; }
    __device__ __forceinline__ void a_ready(const Unit&) const {}
    __device__ __forceinline__ void done(const Unit&) const {}
};
template <class Epi, class Sched>
__device__ __forceinline__ void gemm_phase(LAS unsigned char* lds, const Gemm g, const Sched& S, const Epi& E) {
    const int tid = opaque_tid(), wid = __builtin_amdgcn_readfirstlane(tid >> 6), lane = tid & 63, wr = wid >> 2, wc = wid & 3, fr = lane & 15, fq = lane >> 4;
    const int K = g.K, nt = K / BK;
    unsigned voffA[2], voffB[2];
#pragma unroll
    for (int i = 0; i < 2; ++i) { int R, C; stage_rc(tid * 16 + i * 8192, R, C); const int Rb = Epi::PERM ? ((R & ~31) + perm32(R & 31)) : R;
        voffA[i] = (unsigned)(R * g.lda + C) * 2u; voffB[i] = (unsigned)(Rb * g.ldb + C) * 2u; }
    const size_t kstep = (size_t)(BK * 2);
    const size_t hstepA = (size_t)HALF * g.lda * 2, hstepB = (size_t)HALF * g.ldb * 2;
    const size_t tstepA = 2 * hstepA, tstepB = 2 * hstepB;
    const unsigned ldsw = (unsigned)wid * 1024u;
    const int aoff = lds_byte(wr * 64 + fr, fq * 8), boff = lds_byte(wc * 32 + fr, fq * 8);
#define PG8_SA(b, h) (((b) * 2 + (h)) * HTB)
#define PG8_SB(b, h) ((4 + (b) * 2 + (h)) * HTB)
#define PG8_STAGE(bufoff, gbase, voff) do { _Pragma("unroll") for (int _i = 0; _i < 2; ++_i) \
        __builtin_amdgcn_global_load_lds((const unsigned*)((const char*)(gbase) + (voff)[_i]), (LAS unsigned*)(lds + (bufoff) + ldsw + _i * 8192), 16, 0, 0); } while (0)
#define PG8_LDA(dst, b, h) do { _Pragma("unroll") for (int m = 0; m < 4; ++m) _Pragma("unroll") for (int k = 0; k < 2; ++k) dst[m][k] = *(const LAS bf16x8*)(lds + PG8_SA(b, h) + aoff + m * 2048 + k * 1024); } while (0)
#define PG8_LDB(dst, b, h) do { _Pragma("unroll") for (int n = 0; n < 2; ++n) _Pragma("unroll") for (int k = 0; k < 2; ++k) dst[n][k] = *(const LAS bf16x8*)(lds + PG8_SB(b, h) + boff + n * 2048 + k * 1024); } while (0)
#define PG8_MMA(ai, bj, At, Bt) do { __builtin_amdgcn_s_setprio(1); _Pragma("unroll") for (int m = 0; m < 4; ++m) _Pragma("unroll") for (int n = 0; n < 2; ++n) _Pragma("unroll") for (int k = 0; k < 2; ++k) \
        acc[ai][bj][m][n] = __builtin_amdgcn_mfma_f32_16x16x32_bf16(Bt[n][k], At[m][k], acc[ai][bj][m][n], 0, 0, 0); __builtin_amdgcn_s_setprio(0); } while (0)
#define PG8_WAIT_V(n) asm volatile("s_waitcnt vmcnt(" #n ")" ::: "memory")
#define PG8_WAIT_L(n) asm volatile("s_waitcnt lgkmcnt(" #n ")" ::: "memory")
#define PG8_BAR __builtin_amdgcn_s_barrier()
#define PG8_SCHED __builtin_amdgcn_sched_barrier(0)
    Unit cur, nxt; int ui = 0;
    if (!S.next(0, cur)) return;
    f32x4 acc[2][2][4][2];
#pragma unroll
    for (int a = 0; a < 2; ++a)
#pragma unroll
        for (int b = 0; b < 2; ++b)
#pragma unroll
            for (int m = 0; m < 4; ++m)
#pragma unroll
                for (int n = 0; n < 2; ++n) acc[a][b][m][n] = (f32x4){0.f, 0.f, 0.f, 0.f};
    bf16x8 At[4][2], B0[2][2], B1[2][2];
    const char* cA = (const char*)g.A + (size_t)cur.pm * tstepA; const char* cB = (const char*)g.Bt + (size_t)cur.pn * tstepB;
    S.a_ready(cur);
    PG8_STAGE(PG8_SB(0, 0), cB, voffB); PG8_STAGE(PG8_SA(0, 0), cA, voffA); PG8_STAGE(PG8_SB(0, 1), cB + hstepB, voffB); PG8_STAGE(PG8_SA(0, 1), cA + hstepA, voffA);
    if (wr == 1) PG8_BAR;
    PG8_WAIT_V(4); PG8_BAR;
    PG8_STAGE(PG8_SB(1, 0), cB + kstep, voffB); PG8_STAGE(PG8_SA(1, 0), cA + kstep, voffA); PG8_STAGE(PG8_SB(1, 1), cB + hstepB + kstep, voffB);
    PG8_WAIT_V(6); PG8_BAR;
    for (;;) {
        const bool has_next = S.next(ui + 1, nxt);
        const char* nA = has_next ? (const char*)g.A + (size_t)nxt.pm * tstepA : cA; const char* nB = has_next ? (const char*)g.Bt + (size_t)nxt.pn * tstepB : cB;
        for (int t = 0; t < nt; t += 2) {
            const bool last = (t == nt - 2);
            const char* a1 = cA + (size_t)(t + 1) * kstep;
            const char* a2 = last ? nA : cA + (size_t)(t + 2) * kstep; const char* b2 = last ? nB : cB + (size_t)(t + 2) * kstep;
            const char* a3 = a2 + kstep; const char* b3 = b2 + kstep;
            if (last && has_next) S.a_ready(nxt);
            PG8_LDB(B0, 0, 0); PG8_SCHED; PG8_LDA(At, 0, 0); PG8_STAGE(PG8_SA(1, 1), a1 + hstepA, voffA);
            PG8_WAIT_L(8); PG8_BAR; PG8_WAIT_L(0); PG8_MMA(0, 0, At, B0); PG8_BAR; PG8_SCHED;
            PG8_LDB(B1, 0, 1); PG8_STAGE(PG8_SB(0, 0), b2, voffB);
            PG8_BAR; PG8_WAIT_L(0); PG8_MMA(0, 1, At, B1); PG8_BAR;
            PG8_LDA(At, 0, 1); PG8_STAGE(PG8_SA(0, 0), a2, voffA);
            PG8_BAR; PG8_WAIT_L(0); PG8_MMA(1, 0, At, B0); PG8_BAR; PG8_SCHED;
            PG8_STAGE(PG8_SB(0, 1), b2 + hstepB, voffB);
            PG8_WAIT_V(6); PG8_BAR; PG8_MMA(1, 1, At, B1); PG8_BAR;
            PG8_LDB(B0, 1, 0); PG8_SCHED; PG8_LDA(At, 1, 0); PG8_STAGE(PG8_SA(0, 1), a2 + hstepA, voffA);
            PG8_WAIT_L(8); PG8_BAR; PG8_WAIT_L(0); PG8_MMA(0, 0, At, B0); PG8_BAR; PG8_SCHED;
            PG8_LDB(B1, 1, 1); PG8_STAGE(PG8_SB(1, 0), b3, voffB);
            PG8_BAR; PG8_WAIT_L(0); PG8_MMA(0, 1, At, B1); PG8_BAR;
            PG8_LDA(At, 1, 1); PG8_STAGE(PG8_SA(1, 0), a3, voffA);
            PG8_BAR; PG8_WAIT_L(0); PG8_MMA(1, 0, At, B0); PG8_BAR; PG8_SCHED;
            PG8_STAGE(PG8_SB(1, 1), b3 + hstepB, voffB);
            PG8_WAIT_V(6); PG8_BAR; PG8_MMA(1, 1, At, B1); PG8_BAR;
        }
        E(acc, cur, wr, wc, fr, fq); S.done(cur);
        if (!has_next) break;
#pragma unroll
        for (int a = 0; a < 2; ++a)
#pragma unroll
            for (int b = 0; b < 2; ++b)
#pragma unroll
                for (int m = 0; m < 4; ++m)
#pragma unroll
                    for (int n = 0; n < 2; ++n) acc[a][b][m][n] = (f32x4){0.f, 0.f, 0.f, 0.f};
        cur = nxt; cA = nA; cB = nB; ++ui;
    }
    PG8_WAIT_V(0);
    if (wr == 0) PG8_BAR;
    PG8_BAR;
#undef PG8_SA
#undef PG8_SB
#undef PG8_STAGE
#undef PG8_LDA
#undef PG8_LDB
#undef PG8_MMA
#undef PG8_WAIT_V
#undef PG8_WAIT_L
#undef PG8_BAR
#undef PG8_SCHED
}

struct EpiRes {
    static constexpr bool PERM = false;
    float* X; int ldc;
    __device__ __forceinline__ void operator()(const f32x4 (&acc)[2][2][4][2], const Unit& u, int wr, int wc, int fr, int fq) const {
        const int row0 = u.pm * BM + wr * 64 + fr, col0 = u.pn * BM + wc * 32 + 4 * fq;
#pragma unroll
        for (int ai = 0; ai < 2; ++ai)
#pragma unroll
            for (int m = 0; m < 4; ++m) { float* rowp = X + (size_t)(row0 + ai * HALF + m * 16) * ldc + col0;
                f32x4 o[2][2];
#pragma unroll
                for (int bj = 0; bj < 2; ++bj)
#pragma unroll
                    for (int n = 0; n < 2; ++n) o[bj][n] = *(const f32x4*)(rowp + bj * HALF + n * 16);
#pragma unroll
                for (int bj = 0; bj < 2; ++bj)
#pragma unroll
                    for (int n = 0; n < 2; ++n) *(f32x4*)(rowp + bj * HALF + n * 16) = o[bj][n] + acc[ai][bj][m][n];
                asm volatile("" ::: "memory"); }
    }
};
struct EpiResB {
    static constexpr bool PERM = true;
    bf16_t* XB; int ldc;
    __device__ __forceinline__ void operator()(const f32x4 (&acc)[2][2][4][2], const Unit& u, int wr, int wc, int fr, int fq) const {
        const int row0 = u.pm * BM + wr * 64 + fr, col0 = u.pn * BM + wc * 32 + 8 * fq;
#pragma unroll
        for (int ai = 0; ai < 2; ++ai) {
            u32x4 o[4][2];
#pragma unroll
            for (int m = 0; m < 4; ++m)
#pragma unroll
                for (int bj = 0; bj < 2; ++bj) o[m][bj] = *(const u32x4*)(XB + (size_t)(row0 + ai * HALF + m * 16) * ldc + col0 + bj * HALF);
            asm volatile("" ::: "memory");
#pragma unroll
            for (int m = 0; m < 4; ++m)
#pragma unroll
                for (int bj = 0; bj < 2; ++bj) { const u32x4 x = o[m][bj]; const f32x4 v0 = acc[ai][bj][m][0], v1 = acc[ai][bj][m][1];
                    u32x4 w; w.x = cvt_pk_bf16(bflo(x.x) + v0[0], bfhi(x.x) + v0[1]); w.y = cvt_pk_bf16(bflo(x.y) + v0[2], bfhi(x.y) + v0[3]);
                    w.z = cvt_pk_bf16(bflo(x.z) + v1[0], bfhi(x.z) + v1[1]); w.w = cvt_pk_bf16(bflo(x.w) + v1[2], bfhi(x.w) + v1[3]);
                    *(u32x4*)(XB + (size_t)(row0 + ai * HALF + m * 16) * ldc + col0 + bj * HALF) = w; }
            asm volatile("" ::: "memory"); }
    }
};
struct EpiResPart {
    static constexpr bool PERM = false;
    float* P; int ldc;
    __device__ __forceinline__ void operator()(const f32x4 (&acc)[2][2][4][2], const Unit& u, int wr, int wc, int fr, int fq) const {
        const int row0 = wr * 64 + fr, col0 = u.pn * BM + wc * 32 + 4 * fq;
#pragma unroll
        for (int m = 0; m < 4; ++m) { float* rowp = P + (size_t)(row0 + m * 16) * ldc + col0;
#pragma unroll
            for (int bj = 0; bj < 2; ++bj)
#pragma unroll
                for (int n = 0; n < 2; ++n) *(f32x4*)(rowp + bj * HALF + n * 16) = acc[0][bj][m][n]; }
    }
};
struct EpiResAtomic {
    static constexpr bool PERM = false;
    float* X; int ldc;
    __device__ __forceinline__ void operator()(const f32x4 (&acc)[2][2][4][2], const Unit& u, int wr, int wc, int fr, int fq) const {
        const int row0 = wr * 64 + fr, col0 = u.pn * BM + wc * 32 + 4 * fq;
#pragma unroll
        for (int m = 0; m < 4; ++m) { float* rowp = X + (size_t)(row0 + m * 16) * ldc + col0;
#pragma unroll
            for (int bj = 0; bj < 2; ++bj)
#pragma unroll
                for (int n = 0; n < 2; ++n)
#pragma unroll
                    for (int j = 0; j < 4; ++j) __hip_atomic_fetch_add(rowp + bj * HALF + n * 16 + j, acc[0][bj][m][n][j], __ATOMIC_RELAXED, __HIP_MEMORY_SCOPE_AGENT); }
    }
};
struct EpiBf {
    static constexpr bool PERM = true;
    bf16_t* O; int ldc;
    __device__ __forceinline__ void operator()(const f32x4 (&acc)[2][2][4][2], const Unit& u, int wr, int wc, int fr, int fq) const {
        const int row0 = u.pm * BM + wr * 64 + fr, col0 = u.pn * BM + wc * 32 + 8 * fq;
#pragma unroll
        for (int ai = 0; ai < 2; ++ai)
#pragma unroll
            for (int m = 0; m < 4; ++m) { bf16_t* rowp = O + (size_t)(row0 + ai * HALF + m * 16) * ldc + col0;
#pragma unroll
                for (int bj = 0; bj < 2; ++bj) { const f32x4 v0 = acc[ai][bj][m][0], v1 = acc[ai][bj][m][1];
                    u32x4 w; w.x = cvt_pk_bf16(v0[0], v0[1]); w.y = cvt_pk_bf16(v0[2], v0[3]); w.z = cvt_pk_bf16(v1[0], v1[1]); w.w = cvt_pk_bf16(v1[2], v1[3]);
                    *(u32x4*)(rowp + bj * HALF) = w; } }
    }
};
struct EpiMem {
    static constexpr bool PERM = false;
    float* C; bf16_t* O; int ldc;
    __device__ __forceinline__ void operator()(const f32x4 (&acc)[2][2][4][2], const Unit& u, int wr, int wc, int fr, int fq) const {
        const int row0 = u.pm * BM + wr * 64 + fr, col0 = u.pn * BM + wc * 32 + 4 * fq;
#pragma unroll
        for (int ai = 0; ai < 2; ++ai)
#pragma unroll
            for (int m = 0; m < 4; ++m) { const size_t ro = (size_t)(row0 + ai * HALF + m * 16) * ldc + col0;
#pragma unroll
                for (int bj = 0; bj < 2; ++bj)
#pragma unroll
                    for (int n = 0; n < 2; ++n) { const f32x4 v = acc[ai][bj][m][n]; *(f32x4*)(C + ro + bj * HALF + n * 16) = v;
                        if (O) { u32x2 w; w.x = cvt_pk_bf16(v[0], v[1]); w.y = cvt_pk_bf16(v[2], v[3]); *(u32x2*)(O + ro + bj * HALF + n * 16) = w; } } }
    }
};
struct EpiGU {
    static constexpr bool PERM = true;
    bf16_t* O;
    __device__ __forceinline__ void operator()(const f32x4 (&acc)[2][2][4][2], const Unit& u, int wr, int wc, int fr, int fq) const {
        const int row0 = u.pm * BM + wr * 64 + fr, col0 = u.pn * 128 + wc * 16 + 4 * fq;
#pragma unroll
        for (int ai = 0; ai < 2; ++ai)
#pragma unroll
            for (int m = 0; m < 4; ++m) { bf16_t* rowp = O + (size_t)(row0 + ai * HALF + m * 16) * DFF + col0;
#pragma unroll
                for (int bj = 0; bj < 2; ++bj) { const f32x4 v0 = acc[ai][bj][m][0], v1 = acc[ai][bj][m][1];
                    u32x2 w; w.x = cvt_pk_bf16(silu_f(v0[0]) * v0[1], silu_f(v0[2]) * v0[3]); w.y = cvt_pk_bf16(silu_f(v1[0]) * v1[1], silu_f(v1[2]) * v1[3]);
                    *(u32x2*)(rowp + bj * 64) = w; } }
    }
};
struct EpiIn {
    static constexpr bool PERM = true;
    bf16_t* P; const float* cs; const float* sn; float* out; int layer;
    __device__ __forceinline__ void operator()(const f32x4 (&acc)[2][2][4][2], const Unit& u, int wr, int wc, int fr, int fq) const {
        const int pn = u.pn, cin = wc * 32 + 8 * fq, rbase = u.pm * BM + wr * 64 + fr;
        const bool rot = pn < 8; const float sc = (pn >= 4 && pn < 8) ? QK_SCALE : 1.f;
#pragma unroll
        for (int ai = 0; ai < 2; ++ai)
#pragma unroll
            for (int m = 0; m < 4; ++m) { const int r = rbase + ai * HALF + m * 16; const int pos = r < SEQ ? r : SEQ;
                f32x4 c4 = (f32x4){1.f, 1.f, 1.f, 1.f}, s4 = (f32x4){0.f, 0.f, 0.f, 0.f};
                if (rot) { c4 = *(const f32x4*)(cs + (size_t)pos * 64 + (cin >> 1)); s4 = *(const f32x4*)(sn + (size_t)pos * 64 + (cin >> 1)); }
#pragma unroll
                for (int bj = 0; bj < 2; ++bj) { const f32x4 v0 = acc[ai][bj][m][0], v1 = acc[ai][bj][m][1];
                    const int cc = bj * HALF + cin;
                    float o[8];
                    o[0] = (v0[0] * c4[0] - v0[1] * s4[0]) * sc; o[1] = (v0[0] * s4[0] + v0[1] * c4[0]) * sc;
                    o[2] = (v0[2] * c4[1] - v0[3] * s4[1]) * sc; o[3] = (v0[2] * s4[1] + v0[3] * c4[1]) * sc;
                    o[4] = (v1[0] * c4[2] - v1[1] * s4[2]) * sc; o[5] = (v1[0] * s4[2] + v1[1] * c4[2]) * sc;
                    o[6] = (v1[2] * c4[3] - v1[3] * s4[3]) * sc; o[7] = (v1[2] * s4[3] + v1[3] * c4[3]) * sc;
                    if (!rot) { o[0] = v0[0]; o[1] = v0[1]; o[2] = v0[2]; o[3] = v0[3]; o[4] = v1[0]; o[5] = v1[1]; o[6] = v1[2]; o[7] = v1[3]; }
                    u32x4 w; w.x = cvt_pk_bf16(o[0], o[1]); w.y = cvt_pk_bf16(o[2], o[3]); w.z = cvt_pk_bf16(o[4], o[5]); w.w = cvt_pk_bf16(o[6], o[7]);
                    *(u32x4*)(P + (size_t)r * INW + pn * BM + cc) = w;
                    if (pn >= 20) {
                        float* dst = nullptr;
                        if (r >= SEQ - 128 && r < SEQ) dst = out + OFF_WKP + (size_t)(pn - 20) * 65536 + (size_t)layer * 32768 + (size_t)(r - (SEQ - 128)) * 256 + cc;
                        else if (r >= SEQ && r < MROWS) dst = out + OFF_WKS + (size_t)(pn - 20) * 8388608 + ((size_t)(layer * 128 + (r - SEQ)) * 128 + 127) * 256 + cc;
                        if (dst) { *(f32x4*)dst = v0; *(f32x4*)(dst + 4) = v1; }
                    } } }
    }
};
}

__device__ __forceinline__ int rowmap(int mode, int n) {
    if (mode == 1) { if (n < 2048) { const int hd = n >> 7, d = n & 127; return (hd << 7) + ((d & 63) << 1) + (d >> 6); } return n; }
    if (mode == 2) return 2 * n;
    if (mode == 3) return 2 * n + 1;
    return n;
}
__device__ void convT(const float* __restrict__ src, int K, int N, bf16_t* __restrict__ dst, int mode, float* tile  , int brot, int vb, int vG) {
    const int TX = opaque_tid(); const int BX = opaque_bid(); (void)BX;
    const int tn = N >> 7, tk = K >> 6, nt = tn * tk, t = TX;
    const int n4 = (t & 31) * 4, kk = t >> 5;
    const int sn = t >> 2, kc = (t & 3) * 16;
    int ti = (vb + brot) % vG;
    f32x4 v[4];
    if (ti < nt) { const int k0 = (ti / tn) << 6, n0 = (ti % tn) << 7;
#pragma unroll
        for (int i = 0; i < 4; ++i) v[i] = *(const f32x4*)(src + (size_t)(k0 + kk + 16 * i) * N + n0 + n4); }
    for (; ti < nt; ti += vG) {
        const int k0 = (ti / tn) << 6, n0 = (ti % tn) << 7;
        const int tnx = ti + vG;
        f32x4 nv[4];
        if (tnx < nt) { const int k1 = (tnx / tn) << 6, n1 = (tnx % tn) << 7;
#pragma unroll
            for (int i = 0; i < 4; ++i) nv[i] = *(const f32x4*)(src + (size_t)(k1 + kk + 16 * i) * N + n1 + n4); }
        else {
#pragma unroll
            for (int i = 0; i < 4; ++i) nv[i] = (f32x4){0.f, 0.f, 0.f, 0.f}; }
        __syncthreads();
#pragma unroll
        for (int i = 0; i < 4; ++i)
#pragma unroll
            for (int j = 0; j < 4; ++j) tile[(n4 + j) * 65 + kk + 16 * i] = v[i][j];
        __syncthreads();
        const float* tp = tile + sn * 65 + kc;
        u32x4 w0, w1;
        w0.x = cvt_pk_bf16(tp[0], tp[1]); w0.y = cvt_pk_bf16(tp[2], tp[3]); w0.z = cvt_pk_bf16(tp[4], tp[5]); w0.w = cvt_pk_bf16(tp[6], tp[7]);
        w1.x = cvt_pk_bf16(tp[8], tp[9]); w1.y = cvt_pk_bf16(tp[10], tp[11]); w1.z = cvt_pk_bf16(tp[12], tp[13]); w1.w = cvt_pk_bf16(tp[14], tp[15]);
        bf16_t* dp = dst + (size_t)rowmap(mode, n0 + sn) * K + k0 + kc;
        *(u32x4*)dp = w0; *(u32x4*)(dp + 8) = w1;
#pragma unroll
        for (int i = 0; i < 4; ++i) v[i] = nv[i];
    }
    __syncthreads();
}

__device__ void rms_phase(const Args& a, int mode, const float* __restrict__ g, int nparts, unsigned char* shm) {
    const int TX = opaque_tid(); const int BX = opaque_bid(); (void)BX;
    float* X = (float*)(a.ws + WS_X); bf16_t* H = (bf16_t*)(a.ws + WS_H); bf16_t* XB = (bf16_t*)(a.ws + WS_XB);
    const int lane = TX & 63, wv = TX >> 6, gw = BX * 8 + wv, nw = gridDim.x * 8;
    if (mode != 0) {
        float* red = (float*)shm;
        for (int rs = BX; rs < NBAT; rs += gridDim.x) { const int r = SEQ + rs;
            f32x4 v[8];
#pragma unroll
            for (int ch = 0; ch < 4; ++ch) { const int col = ch * 512 + lane * 8;
                if (wv == 0) { v[2 * ch] = *(const f32x4*)(X + (size_t)r * DM + col); v[2 * ch + 1] = *(const f32x4*)(X + (size_t)r * DM + col + 4); }
                else { v[2 * ch] = (f32x4){0.f, 0.f, 0.f, 0.f}; v[2 * ch + 1] = (f32x4){0.f, 0.f, 0.f, 0.f}; } }
            const float* part = (const float*)(a.ws + WS_PART) + (size_t)rs * DM;
            for (int ks = wv; ks < nparts; ks += 8) {
#pragma unroll
                for (int ch = 0; ch < 4; ++ch) { const int col = ch * 512 + lane * 8;
                    v[2 * ch] += *(const f32x4*)(part + (size_t)ks * 128 * DM + col); v[2 * ch + 1] += *(const f32x4*)(part + (size_t)ks * 128 * DM + col + 4); } }
            __syncthreads();
            if (wv != 0) {
#pragma unroll
                for (int ch = 0; ch < 4; ++ch) { const int col = ch * 512 + lane * 8;
                    *(f32x4*)(red + wv * DM + col) = v[2 * ch]; *(f32x4*)(red + wv * DM + col + 4) = v[2 * ch + 1]; } }
            __syncthreads();
            if (wv == 0) {
                const int nwv = nparts < 8 ? nparts : 8;
                float ss = 0.f;
#pragma unroll
                for (int ch = 0; ch < 4; ++ch) { const int col = ch * 512 + lane * 8;
                    for (int q = 1; q < nwv; ++q) { v[2 * ch] += *(const f32x4*)(red + q * DM + col); v[2 * ch + 1] += *(const f32x4*)(red + q * DM + col + 4); }
                    *(f32x4*)(X + (size_t)r * DM + col) = v[2 * ch]; *(f32x4*)(X + (size_t)r * DM + col + 4) = v[2 * ch + 1];
#pragma unroll
                    for (int j = 0; j < 4; ++j) ss += v[2 * ch][j] * v[2 * ch][j] + v[2 * ch + 1][j] * v[2 * ch + 1][j]; }
                ss = red64_sum(ss);
                const float rstd = rsqrtf(ss * (1.f / DM) + EPS);
#pragma unroll
                for (int ch = 0; ch < 4; ++ch) { const int col = ch * 512 + lane * 8;
                    const f32x4 g0 = *(const f32x4*)(g + col), g1 = *(const f32x4*)(g + col + 4);
                    const f32x4 y0 = v[2 * ch] * rstd * g0, y1 = v[2 * ch + 1] * rstd * g1;
                    if (mode == 2) { *(f32x4*)(a.out + (size_t)r * DM + col) = y0; *(f32x4*)(a.out + (size_t)r * DM + col + 4) = y1; }
                    else { u32x4 w; w.x = cvt_pk_bf16(y0[0], y0[1]); w.y = cvt_pk_bf16(y0[2], y0[3]); w.z = cvt_pk_bf16(y1[0], y1[1]); w.w = cvt_pk_bf16(y1[2], y1[3]);
                        *(u32x4*)(H + (size_t)r * DM + col) = w; } }
            }
        }
    }
    const int rend = mode == 0 ? MP : SEQ;
    for (int r = gw; r < rend; r += nw) {
        f32x4 v[8]; float ss = 0.f;
        if (mode != 0) {
#pragma unroll
            for (int ch = 0; ch < 4; ++ch) { const u32x4 raw = *(const u32x4*)(XB + (size_t)r * DM + ch * 512 + lane * 8);
                v[2 * ch] = (f32x4){bflo(raw.x), bfhi(raw.x), bflo(raw.y), bfhi(raw.y)}; v[2 * ch + 1] = (f32x4){bflo(raw.z), bfhi(raw.z), bflo(raw.w), bfhi(raw.w)}; }
        } else {
            const float* src = nullptr;
            if (r < SEQ) src = a.in[0] + (size_t)r * DM; else if (r < MROWS) src = a.in[1] + (size_t)(r - SEQ) * DM;
#pragma unroll
            for (int ch = 0; ch < 4; ++ch) { const int col = ch * 512 + lane * 8;
                if (src) { v[2 * ch] = *(const f32x4*)(src + col); v[2 * ch + 1] = *(const f32x4*)(src + col + 4); }
                else { v[2 * ch] = (f32x4){0.f, 0.f, 0.f, 0.f}; v[2 * ch + 1] = (f32x4){0.f, 0.f, 0.f, 0.f}; } }
        }
#pragma unroll
        for (int i = 0; i < 8; ++i)
#pragma unroll
            for (int j = 0; j < 4; ++j) ss += v[i][j] * v[i][j];
        ss = red64_sum(ss);
        const float rstd = rsqrtf(ss * (1.f / DM) + EPS);
#pragma unroll
        for (int ch = 0; ch < 4; ++ch) { const int col = ch * 512 + lane * 8;
            const f32x4 g0 = *(const f32x4*)(g + col), g1 = *(const f32x4*)(g + col + 4);
            const f32x4 y0 = v[2 * ch] * rstd * g0, y1 = v[2 * ch + 1] * rstd * g1;
            if (mode == 0) {
                if (r < SEQ) { u32x4 w; w.x = cvt_pk_bf16(v[2 * ch][0], v[2 * ch][1]); w.y = cvt_pk_bf16(v[2 * ch][2], v[2 * ch][3]); w.z = cvt_pk_bf16(v[2 * ch + 1][0], v[2 * ch + 1][1]); w.w = cvt_pk_bf16(v[2 * ch + 1][2], v[2 * ch + 1][3]);
                    *(u32x4*)(XB + (size_t)r * DM + col) = w; }
                else { *(f32x4*)(X + (size_t)r * DM + col) = v[2 * ch]; *(f32x4*)(X + (size_t)r * DM + col + 4) = v[2 * ch + 1]; } }
            if (mode == 2) { *(f32x4*)(a.out + (size_t)r * DM + col) = y0; *(f32x4*)(a.out + (size_t)r * DM + col + 4) = y1; }
            else { u32x4 w; w.x = cvt_pk_bf16(y0[0], y0[1]); w.y = cvt_pk_bf16(y0[2], y0[3]); w.z = cvt_pk_bf16(y1[0], y1[1]); w.w = cvt_pk_bf16(y1[2], y1[3]);
                *(u32x4*)(H + (size_t)r * DM + col) = w; } }
    }
}

__device__ __forceinline__ void load_T128(const bf16_t* __restrict__ src, size_t ld, bf16_t* dst, int dstStride, int colOff, bool zeta, float lg2, bool zero) {
    const int TX = opaque_tid(); const int BX = opaque_bid(); (void)BX;
    const int t = TX;
#pragma unroll
    for (int i = 0; i < 4; ++i) {
        const int m = (t & 31) + 32 * i, c8 = (t >> 5) * 8;
        u32x4 raw = (u32x4){0u, 0u, 0u, 0u};
        if (!zero) raw = *(const u32x4*)(src + (size_t)m * ld + c8);
        const float sc = zeta ? exp2f(lg2 * (float)(127 - m)) : 1.f;
#pragma unroll
        for (int e = 0; e < 4; ++e) { const unsigned w = raw[e];
            bf16_t lo = (bf16_t)(w & 0xffffu), hi = (bf16_t)(w >> 16);
            if (zeta) { lo = f2bf(bflo(w) * sc); hi = f2bf(bfhi(w) * sc); }
            dst[(c8 + 2 * e) * dstStride + colOff + m] = lo; dst[(c8 + 2 * e + 1) * dstStride + colOff + m] = hi; }
    }
}


template <int NROWS, int CPR>
__device__ __forceinline__ void stage_rows(const bf16_t* __restrict__ src, size_t ld, bf16_t* dst, int dstStride, int tx) {
    constexpr int TOT = NROWS * CPR;
#pragma unroll
    for (int i = 0; i < TOT / 512; ++i) { const int q = tx + 512 * i, r = q / CPR, c = q % CPR;
        *(u32x4*)(dst + r * dstStride + c * 8) = *(const u32x4*)(src + (size_t)r * ld + c * 8); }
}


typedef short v4s_t __attribute__((ext_vector_type(4)));
__device__ __forceinline__ bf16x8 ld8_tr(const bf16_t* tile, int row0, int stride, int col0, int fq, int fr) {
    typedef __attribute__((address_space(3))) v4s_t* lp_t;
    const int q = fr >> 2, p = fr & 3;
    const v4s_t lo = __builtin_amdgcn_ds_read_tr16_b64_v4i16((lp_t)(tile + (row0 + 8 * fq + q) * stride + col0 + 4 * p));
    const v4s_t hi = __builtin_amdgcn_ds_read_tr16_b64_v4i16((lp_t)(tile + (row0 + 8 * fq + 4 + q) * stride + col0 + 4 * p));
    return (bf16x8){lo[0], lo[1], lo[2], lo[3], hi[0], hi[1], hi[2], hi[3]};
}
template <int NROWS, int CPR>
__device__ __forceinline__ void zero_rows(bf16_t* dst, int dstStride, int tx) {
#pragma unroll
    for (int i = 0; i < NROWS * CPR / 512; ++i) { const int q = tx + 512 * i, r = q / CPR, c = q % CPR; *(u32x4*)(dst + r * dstStride + c * 8) = (u32x4){0u, 0u, 0u, 0u}; }
}

__device__ __forceinline__ void ret_kv_item(const Args& a, int n, int h, unsigned char* shm) {
    const int TX = opaque_tid(); const int BX = opaque_bid(); (void)BX;
    const bf16_t* PROJ = (const bf16_t*)(a.ws + WS_PROJ); float* KVT = (float*)(a.ws + WS_KVT);
    bf16_t* kT = (bf16_t*)shm; bf16_t* vT = kT + 128 * 136;
    const int lane = TX & 63, w = TX >> 6, fr = lane & 15, fq = lane >> 4;
    const float lg2 = ret_lg2(h);
    const bf16_t* base = PROJ + (size_t)(n * 128) * INW + h * 128;
    __syncthreads();
    load_T128(base + 1024, INW, kT, 136, 0, true, lg2, false);
    load_T128(base + 2048, INW, vT, 136, 0, false, 0.f, false);
    __syncthreads();
    f32x4 acc[8];
#pragma unroll
    for (int t = 0; t < 8; ++t) acc[t] = (f32x4){0.f, 0.f, 0.f, 0.f};
#pragma unroll
    for (int ks = 0; ks < 4; ++ks) { const bf16x8 av = ld8(vT + (16 * w + fr) * 136 + ks * 32 + fq * 8);
#pragma unroll
        for (int t = 0; t < 8; ++t) acc[t] = mfma16(av, ld8(kT + (16 * t + fr) * 136 + ks * 32 + fq * 8), acc[t]); }
    float* dst = KVT + ((size_t)(n * 8 + h) << 14);
#pragma unroll
    for (int t = 0; t < 8; ++t)
#pragma unroll
        for (int j = 0; j < 4; ++j) dst[(16 * w + fq * 4 + j) * 128 + 16 * t + fr] = acc[t][j];
}

__device__ void ret_scan_phase(const Args& a, int l) {
    const int TX = opaque_tid(); const int BX = opaque_bid(); (void)BX;
    float* KVT = (float*)(a.ws + WS_KVT); bf16_t* RT = (bf16_t*)(a.ws + WS_RT);
    for (int e = BX * 512 + TX; e < 8 * 16384; e += gridDim.x * 512) {
        const int h = e >> 14, rem = e & 16383;
        const float g = exp2f(ret_lg2(h) * 128.f);
        float r = 0.f;
#pragma unroll 8
        for (int n = 0; n < 64; ++n) { const size_t off = ((size_t)(n * 8 + h) << 14) + rem; const float kv = KVT[off]; RT[off] = f2bf(r); r = g * r + kv; }
        const int dv = rem >> 7, p = rem & 127, dt = (p >> 1) + 64 * (p & 1);
        a.out[OFF_RETP + (size_t)l * 131072 + (size_t)(h * 128 + dt) * 128 + dv] = r;
    }
}

__device__ __forceinline__ void ret_out_item(const Args& a, int l, int n, int h, unsigned char* shm) {
    const int TX = opaque_tid(); const int BX = opaque_bid(); (void)BX;
    const bf16_t* PROJ = (const bf16_t*)(a.ws + WS_PROJ); const bf16_t* RT = (const bf16_t*)(a.ws + WS_RT); bf16_t* MIX = (bf16_t*)(a.ws + WS_MIX);
    const int lane = TX & 63, w = __builtin_amdgcn_readfirstlane(TX >> 6), fr = lane & 15, fq = lane >> 4;
    bf16_t* vT = (bf16_t*)shm; bf16_t* Ks = vT + 128 * 136; bf16_t* Rs = Ks + 128 * 136; bf16_t* Pw = Rs + 128 * 136 + w * (16 * 136);
    const float lg2 = ret_lg2(h);
    const int rowbase = n * 128;
    const bf16_t* base = PROJ + (size_t)rowbase * INW + h * 128;
    __syncthreads();
    stage_rows<128, 16>(base + 2048, INW, vT, 136, TX);
    stage_rows<128, 16>(base + 1024, INW, Ks, 136, TX);
    stage_rows<128, 16>(RT + ((size_t)(n * 8 + h) << 14), 128, Rs, 136, TX);
    bf16x8 qa[4];
#pragma unroll
    for (int ks = 0; ks < 4; ++ks) qa[ks] = ld8(base + (size_t)(16 * w + fr) * INW + ks * 32 + fq * 8);
    __syncthreads();
    for (int t = 0; t <= w; ++t) {
        f32x4 s = (f32x4){0.f, 0.f, 0.f, 0.f};
#pragma unroll
        for (int ks = 0; ks < 4; ++ks) s = mfma16(qa[ks], ld8(Ks + (16 * t + fr) * 136 + ks * 32 + fq * 8), s);
#pragma unroll
        for (int j = 0; j < 4; ++j) { const int diff = (16 * w + fq * 4 + j) - (16 * t + fr);
            const float val = diff >= 0 ? s[j] * exp2f(lg2 * (float)diff) : 0.f;
            Pw[(fq * 4 + j) * 136 + 16 * t + fr] = f2bf(val); }
    }
    if ((w & 1) == 0) {
#pragma unroll
        for (int j = 0; j < 4; ++j) Pw[(fq * 4 + j) * 136 + 16 * (w + 1) + fr] = 0;
    }
    __syncthreads();
    f32x4 oi[8], oc[8];
#pragma unroll
    for (int t = 0; t < 8; ++t) { oi[t] = (f32x4){0.f, 0.f, 0.f, 0.f}; oc[t] = (f32x4){0.f, 0.f, 0.f, 0.f}; }
    const int nks = (w >> 1) + 1;
    for (int ks = 0; ks < nks; ++ks) { const bf16x8 pa = ld8(Pw + fr * 136 + ks * 32 + fq * 8);
#pragma unroll
        for (int t = 0; t < 8; ++t) oi[t] = mfma16(pa, ld8_tr(vT, ks * 32, 136, 16 * t, fq, fr), oi[t]); }
#pragma unroll
    for (int ks = 0; ks < 4; ++ks)
#pragma unroll
        for (int t = 0; t < 8; ++t) oc[t] = mfma16(qa[ks], ld8(Rs + (16 * t + fr) * 136 + ks * 32 + fq * 8), oc[t]);
    const float* gn = a.in[10] + l * 1024 + h * 128;
#pragma unroll
    for (int i = 0; i < 4; ++i) { const int row = lane >> 2, ch = (lane & 3) + 4 * i;
        *(u32x4*)(Pw + row * 136 + ch * 8) = *(const u32x4*)(base + (size_t)(16 * w + row) * INW + 3072 + ch * 8); }
#pragma unroll
    for (int j = 0; j < 4; ++j) { const int c = 16 * w + fq * 4 + j; const float xi = exp2f(lg2 * (float)(c + 1));
        float ss = 0.f;
#pragma unroll
        for (int t = 0; t < 8; ++t) { const float o = oi[t][j] + xi * oc[t][j]; oi[t][j] = o; ss += o * o; }
        ss = red16_sum(ss);
        const float rstd = rsqrtf(ss * (1.f / 128.f) + EPS);
#pragma unroll
        for (int t = 0; t < 8; ++t) { const int dv = 16 * t + fr;
            const float gate = bf2f(Pw[(fq * 4 + j) * 136 + dv]);
            Pw[(fq * 4 + j) * 136 + dv] = f2bf(oi[t][j] * rstd * gn[dv] * silu_f(gate)); } }
#pragma unroll
    for (int i = 0; i < 4; ++i) { const int row = lane >> 2, ch = (lane & 3) + 4 * i;
        *(u32x4*)(MIX + (size_t)(rowbase + 16 * w + row) * DM + h * 128 + ch * 8) = *(const u32x4*)(Pw + row * 136 + ch * 8); }
}

__device__ __forceinline__ void swa_prompt_item(const Args& a, int l, int nb, int hq, unsigned char* shm) {
    const int TX = opaque_tid(); const int BX = opaque_bid(); (void)BX;
    const bf16_t* PROJ = (const bf16_t*)(a.ws + WS_PROJ); bf16_t* MIX = (bf16_t*)(a.ws + WS_MIX);
    const int lane = TX & 63, w = __builtin_amdgcn_readfirstlane(TX >> 6), fr = lane & 15, fq = lane >> 4;
    bf16_t* Vs = (bf16_t*)shm; bf16_t* Ks = Vs + 256 * 136;
    bf16_t* Pw = Ks + w * (16 * 168);
    const int kvh = hq >> 2, blk = nb * 128;
    const int kcol = 5120 + kvh * 128, vcol = 5376 + kvh * 128;
    __syncthreads();
    if (nb > 0) { stage_rows<128, 16>(PROJ + (size_t)(blk - 128) * INW + vcol, INW, Vs, 136, TX); stage_rows<128, 16>(PROJ + (size_t)(blk - 128) * INW + kcol, INW, Ks, 136, TX); }
    else { zero_rows<128, 16>(Vs, 136, TX); zero_rows<128, 16>(Ks, 136, TX); }
    stage_rows<128, 16>(PROJ + (size_t)blk * INW + vcol, INW, Vs + 128 * 136, 136, TX);
    stage_rows<128, 16>(PROJ + (size_t)blk * INW + kcol, INW, Ks + 128 * 136, 136, TX);
    bf16x8 qa[4];
#pragma unroll
    for (int ks = 0; ks < 4; ++ks) qa[ks] = ld8(PROJ + (size_t)(blk + 16 * w + fr) * INW + 4096 + hq * 128 + ks * 32 + fq * 8);
    const int kstart = 32 * (w >> 1);
    __syncthreads();
    const int wo = w & 1;
    f32x4 s[10];
#pragma unroll
    for (int t = 0; t < 10; ++t) { s[t] = (f32x4){0.f, 0.f, 0.f, 0.f};
        const bool dead = (t == 9 && wo == 0) || (t == 0 && wo == 1);
        if (!dead) {
#pragma unroll
            for (int ks = 0; ks < 4; ++ks) s[t] = mfma16(qa[ks], ld8(Ks + (kstart + 16 * t + fr) * 136 + ks * 32 + fq * 8), s[t]); } }
    const float sink = a.in[11][l * 8 + hq];
#pragma unroll
    for (int j = 0; j < 4; ++j) { const int i = 16 * w + fq * 4 + j;
        float mx = sink;
#pragma unroll
        for (int t = 0; t < 10; ++t) { const int sidx = kstart + 16 * t + fr;
            const bool dead = (t == 9 && wo == 0) || (t == 0 && wo == 1);
            const bool edge = (t == wo) || (t == 8 + wo) || (nb == 0);
            float v;
            if (dead) v = -1e30f;
            else if (edge) { const bool valid = (sidx >= i) && (sidx <= i + 128) && (nb > 0 || sidx >= 128); v = valid ? s[t][j] * QK_SCALE : -1e30f; }
            else v = s[t][j] * QK_SCALE;
            s[t][j] = v; mx = fmaxf(mx, v); }
        mx = red16_max(mx);
        float sum = 0.f;
#pragma unroll
        for (int t = 0; t < 10; ++t) { const float p = s[t][j] > -1e29f ? __expf(s[t][j] - mx) : 0.f; s[t][j] = p; sum += p; }
        sum = red16_sum(sum) + __expf(sink - mx);
        const float inv = 1.f / sum;
#pragma unroll
        for (int t = 0; t < 10; ++t) s[t][j] *= inv; }
    __syncthreads();
#pragma unroll
    for (int j = 0; j < 4; ++j)
#pragma unroll
        for (int t = 0; t < 10; ++t) Pw[(fq * 4 + j) * 168 + 16 * t + fr] = f2bf(s[t][j]);
    __syncthreads();
    f32x4 o[8];
#pragma unroll
    for (int t = 0; t < 8; ++t) o[t] = (f32x4){0.f, 0.f, 0.f, 0.f};
#pragma unroll
    for (int ks = 0; ks < 5; ++ks) { const bf16x8 pa = ld8(Pw + fr * 168 + ks * 32 + fq * 8);
#pragma unroll
        for (int t = 0; t < 8; ++t) o[t] = mfma16(pa, ld8_tr(Vs, kstart + ks * 32, 136, 16 * t, fq, fr), o[t]); }
#pragma unroll
    for (int t = 0; t < 8; ++t)
#pragma unroll
        for (int j = 0; j < 4; ++j) Pw[(fq * 4 + j) * 168 + 16 * t + fr] = f2bf(o[t][j]);
#pragma unroll
    for (int i = 0; i < 4; ++i) { const int row = lane >> 2, ch = (lane & 3) + 4 * i;
        *(u32x4*)(MIX + (size_t)(blk + 16 * w + row) * DM + 1024 + hq * 128 + ch * 8) = *(const u32x4*)(Pw + row * 168 + ch * 8); }
}

__device__ __forceinline__ void ret_decode_item(const Args& a, int l, int b, int h, unsigned char* shm) {
    const int TX = opaque_tid(); const int BX = opaque_bid(); (void)BX;
    const bf16_t* PROJ = (const bf16_t*)(a.ws + WS_PROJ); bf16_t* MIX = (bf16_t*)(a.ws + WS_MIX);
    float* qs = (float*)shm; float* ks = qs + 128; float* vs = ks + 128; float* red = vs + 128; float* st = red + 16 * 128;
    const int t = TX; const size_t row = (size_t)(SEQ + b);
    const bf16_t* pr = PROJ + row * INW + h * 128;
    __syncthreads();
    if (t < 128) { const int dt = (t >> 1) + 64 * (t & 1); qs[dt] = bf2f(pr[t]); ks[dt] = bf2f(pr[1024 + t]); }
    else if (t < 256) vs[t - 128] = bf2f(pr[2048 + (t - 128)]);
    __syncthreads();
    const float gamma = 1.f - exp2f(-5.f - (float)h);
    const int dv4 = (t & 31) * 4, dkg = t >> 5;
    const size_t sbase = ((size_t)((l * 128 + b) * 8 + h) << 14);
    const float* S = a.in[3] + sbase; float* So = a.out + OFF_RETS + sbase;
    const f32x4 v4 = *(const f32x4*)(vs + dv4);
    f32x4 o4 = (f32x4){0.f, 0.f, 0.f, 0.f};
    f32x4 svv[8];
#pragma unroll
    for (int i = 0; i < 8; ++i) svv[i] = __builtin_nontemporal_load((const f32x4*)(S + (dkg * 8 + i) * 128 + dv4));
#pragma unroll
    for (int i = 0; i < 8; ++i) { const int dk = dkg * 8 + i;
        const f32x4 sn = svv[i] * gamma + v4 * ks[dk];
        __builtin_nontemporal_store(sn, (f32x4*)(So + dk * 128 + dv4));
        o4 += sn * qs[dk]; }
    *(f32x4*)(red + dkg * 128 + dv4) = o4;
    __syncthreads();
    float o = 0.f;
    if (t < 128) {
#pragma unroll
        for (int g = 0; g < 16; ++g) o += red[g * 128 + t];
        const float ss = red64_sum(o * o);
        if ((t & 63) == 0) st[t >> 6] = ss; }
    __syncthreads();
    if (t < 128) { const float rstd = rsqrtf((st[0] + st[1]) * (1.f / 128.f) + EPS);
        const float gate = bf2f(pr[3072 + t]);
        MIX[row * DM + h * 128 + t] = f2bf(o * rstd * a.in[10][l * 1024 + h * 128 + t] * silu_f(gate)); }
}

__device__ __forceinline__ void swa_decode_item(const Args& a, int l, int b, int kvh, unsigned char* shm) {
    const int TX = opaque_tid(); const int BX = opaque_bid(); (void)BX;
    const bf16_t* PROJ = (const bf16_t*)(a.ws + WS_PROJ); bf16_t* MIX = (bf16_t*)(a.ws + WS_MIX);
    float* sc = (float*)shm;
    float* red = sc + 4 * 132;
    const int t = TX, lane = t & 63, w = t >> 6, l16 = lane & 15, sub = lane >> 4;
    const size_t row = (size_t)(SEQ + b);
    const bf16_t* pr = PROJ + row * INW;
    const size_t cbase = (size_t)(l * 128 + b) * 128 * 256 + kvh * 128;
    const float* ck = a.in[4] + cbase; const float* cv = a.in[5] + cbase;
    float* ok = a.out + OFF_WKS + cbase; float* ov = a.out + OFF_WVS + cbase;
    __syncthreads();
    float q[4][8];
#pragma unroll
    for (int g = 0; g < 4; ++g) { const u32x4 raw = *(const u32x4*)(pr + 4096 + (kvh * 4 + g) * 128 + l16 * 8);
#pragma unroll
        for (int e = 0; e < 4; ++e) { q[g][2 * e] = bflo(raw[e]); q[g][2 * e + 1] = bfhi(raw[e]); } }
    { f32x4 kk[4][2];
#pragma unroll
        for (int it = 0; it < 4; ++it) { const int s = w * 16 + it * 4 + sub;
            kk[it][0] = __builtin_nontemporal_load((const f32x4*)(ck + (size_t)s * 256 + l16 * 8)); kk[it][1] = __builtin_nontemporal_load((const f32x4*)(ck + (size_t)s * 256 + l16 * 8 + 4)); }
#pragma unroll
        for (int it = 0; it < 4; ++it) { const int s = w * 16 + it * 4 + sub;
            const f32x4 k0 = kk[it][0], k1 = kk[it][1];
            if (s >= 1) { __builtin_nontemporal_store(k0, (f32x4*)(ok + (size_t)(s - 1) * 256 + l16 * 8)); __builtin_nontemporal_store(k1, (f32x4*)(ok + (size_t)(s - 1) * 256 + l16 * 8 + 4)); }
#pragma unroll
            for (int g = 0; g < 4; ++g) { float d = 0.f;
#pragma unroll
                for (int e = 0; e < 4; ++e) d += q[g][e] * k0[e] + q[g][4 + e] * k1[e];
                d = red16_sum(d);
                if (l16 == 0) sc[g * 132 + s] = d * QK_SCALE; } } }
    if (w == 0 && sub == 0) {
        const u32x4 raw = *(const u32x4*)(pr + 5120 + kvh * 128 + l16 * 8);
        float kn[8];
#pragma unroll
        for (int e = 0; e < 4; ++e) { kn[2 * e] = bflo(raw[e]); kn[2 * e + 1] = bfhi(raw[e]); }
#pragma unroll
        for (int g = 0; g < 4; ++g) { float d = 0.f;
#pragma unroll
            for (int e = 0; e < 8; ++e) d += q[g][e] * kn[e];
            d = red16_sum(d);
            if (l16 == 0) sc[g * 132 + 128] = d * QK_SCALE; } }
    __syncthreads();
    if (w < 4) { const int g = w; const float sink = a.in[11][l * 8 + kvh * 4 + g];
        const float s0 = sc[g * 132 + lane], s1 = sc[g * 132 + 64 + lane], s2 = lane == 0 ? sc[g * 132 + 128] : -1e30f;
        float mx = fmaxf(fmaxf(s0, s1), fmaxf(s2, sink)); mx = red64_max(mx);
        const float p0 = __expf(s0 - mx), p1 = __expf(s1 - mx), p2 = __expf(s2 - mx);
        const float sum = red64_sum(p0 + p1 + p2) + __expf(sink - mx); const float inv = 1.f / sum;
        sc[g * 132 + lane] = p0 * inv; sc[g * 132 + 64 + lane] = p1 * inv; if (lane == 0) sc[g * 132 + 128] = p2 * inv; }
    __syncthreads();
    { const int dv4 = (t & 31) * 4, grp = t >> 5;
        f32x4 vv[8];
#pragma unroll
        for (int i = 0; i < 8; ++i) vv[i] = __builtin_nontemporal_load((const f32x4*)(cv + (size_t)(grp * 8 + i) * 256 + dv4));
        f32x4 acc[4];
#pragma unroll
        for (int g = 0; g < 4; ++g) acc[g] = (f32x4){0.f, 0.f, 0.f, 0.f};
#pragma unroll
        for (int i = 0; i < 8; ++i) { const int s = grp * 8 + i;
            if (s >= 1) __builtin_nontemporal_store(vv[i], (f32x4*)(ov + (size_t)(s - 1) * 256 + dv4));
#pragma unroll
            for (int g = 0; g < 4; ++g) acc[g] += vv[i] * sc[g * 132 + s]; }
        if (grp == 0) { const u32x2 raw = *(const u32x2*)(pr + 5376 + kvh * 128 + dv4);
            const f32x4 vn = (f32x4){bflo(raw.x), bfhi(raw.x), bflo(raw.y), bfhi(raw.y)};
#pragma unroll
            for (int g = 0; g < 4; ++g) acc[g] += vn * sc[g * 132 + 128]; }
#pragma unroll
        for (int g = 0; g < 4; ++g) *(f32x4*)(red + (grp * 4 + g) * 128 + dv4) = acc[g]; }
    __syncthreads();
    { const int g = t >> 7, dv = t & 127; float o = 0.f;
#pragma unroll
        for (int gr = 0; gr < 16; ++gr) o += red[(gr * 4 + g) * 128 + dv];
        MIX[row * DM + 1024 + (kvh * 4 + g) * 128 + dv] = f2bf(o); }
}

__device__ __forceinline__ void xattn_prompt_item(const Args& a, int l, int rt, int h, unsigned char* shm) {
    const int TX = opaque_tid(); const int BX = opaque_bid(); (void)BX;
    const bf16_t* QC = (const bf16_t*)(a.ws + WS_QC); bf16_t* OC = (bf16_t*)(a.ws + WS_OC);
    const bf16_t* MK = (const bf16_t*)(a.ws + WS_MK) + (size_t)l * MEML * MEMW; const bf16_t* MVT = (const bf16_t*)(a.ws + WS_MVT) + (size_t)l * MEMW * MEML;
    const int lane = TX & 63, w = __builtin_amdgcn_readfirstlane(TX >> 6), fr = lane & 15, fq = lane >> 4;
    bf16_t* KV = (bf16_t*)shm;
    bf16_t* Pw = KV + 256 * 136 + w * (16 * 264);
    const size_t r0 = (size_t)rt * 128 + 16 * w;
    __syncthreads();
    stage_rows<256, 16>(MK + h * 128, MEMW, KV, 136, TX);
    bf16x8 qa[4];
#pragma unroll
    for (int ks = 0; ks < 4; ++ks) qa[ks] = ld8(QC + (r0 + fr) * MEMW + h * 128 + ks * 32 + fq * 8);
    __syncthreads();
    f32x4 s[16];
#pragma unroll
    for (int t = 0; t < 16; ++t) { s[t] = (f32x4){0.f, 0.f, 0.f, 0.f};
#pragma unroll
        for (int ks = 0; ks < 4; ++ks) s[t] = mfma16(qa[ks], ld8(KV + (16 * t + fr) * 136 + ks * 32 + fq * 8), s[t]); }
#pragma unroll
    for (int j = 0; j < 4; ++j) { float mx = -1e30f;
#pragma unroll
        for (int t = 0; t < 16; ++t) { s[t][j] *= QK_SCALE; mx = fmaxf(mx, s[t][j]); }
        mx = red16_max(mx);
        float sum = 0.f;
#pragma unroll
        for (int t = 0; t < 16; ++t) { const float p = __expf(s[t][j] - mx); s[t][j] = p; sum += p; }
        sum = red16_sum(sum); const float inv = 1.f / sum;
#pragma unroll
        for (int t = 0; t < 16; ++t) Pw[(fq * 4 + j) * 264 + 16 * t + fr] = f2bf(s[t][j] * inv); }
    __syncthreads();
    stage_rows<128, 32>(MVT + (size_t)(h * 128) * MEML, MEML, KV, 264, TX);
    __syncthreads();
    f32x4 o[8];
#pragma unroll
    for (int t = 0; t < 8; ++t) o[t] = (f32x4){0.f, 0.f, 0.f, 0.f};
#pragma unroll
    for (int ks = 0; ks < 8; ++ks) { const bf16x8 pa = ld8(Pw + fr * 264 + ks * 32 + fq * 8);
#pragma unroll
        for (int t = 0; t < 8; ++t) o[t] = mfma16(pa, ld8(KV + (16 * t + fr) * 264 + ks * 32 + fq * 8), o[t]); }
#pragma unroll
    for (int t = 0; t < 8; ++t)
#pragma unroll
        for (int j = 0; j < 4; ++j) Pw[(fq * 4 + j) * 264 + 16 * t + fr] = f2bf(o[t][j]);
#pragma unroll
    for (int i = 0; i < 4; ++i) { const int row = lane >> 2, ch = (lane & 3) + 4 * i;
        *(u32x4*)(OC + (r0 + row) * MEMW + h * 128 + ch * 8) = *(const u32x4*)(Pw + row * 264 + ch * 8); }
}

__device__ __forceinline__ void xattn_decode_item(const Args& a, int l, int b, int h, unsigned char* shm) {
    const int TX = opaque_tid(); const int BX = opaque_bid(); (void)BX;
    const bf16_t* QC = (const bf16_t*)(a.ws + WS_QC); bf16_t* OC = (bf16_t*)(a.ws + WS_OC);
    float* sc = (float*)shm;
    float* red = sc + 256;
    const int t = TX, lane = t & 63, w = t >> 6, l16 = lane & 15, sub = lane >> 4;
    const size_t row = (size_t)(SEQ + b);
    const size_t cbase = (size_t)(l * 128 + b) * 256 * 512 + h * 128;
    const float* mk = a.in[6] + cbase; const float* mv = a.in[7] + cbase;
    __syncthreads();
    float q[8];
    { const u32x4 raw = *(const u32x4*)(QC + row * MEMW + h * 128 + l16 * 8);
#pragma unroll
        for (int e = 0; e < 4; ++e) { q[2 * e] = bflo(raw[e]); q[2 * e + 1] = bfhi(raw[e]); } }
#pragma unroll
    for (int it = 0; it < 8; ++it) { const int m = w * 32 + it * 4 + sub;
        const f32x4 k0 = __builtin_nontemporal_load((const f32x4*)(mk + (size_t)m * 512 + l16 * 8)), k1 = __builtin_nontemporal_load((const f32x4*)(mk + (size_t)m * 512 + l16 * 8 + 4));
        float d = 0.f;
#pragma unroll
        for (int e = 0; e < 4; ++e) d += q[e] * k0[e] + q[4 + e] * k1[e];
        d = red16_sum(d);
        if (l16 == 0) sc[m] = d * QK_SCALE; }
    __syncthreads();
    const float s0 = sc[lane], s1 = sc[64 + lane], s2 = sc[128 + lane], s3 = sc[192 + lane];
    float mx = red64_max(fmaxf(fmaxf(s0, s1), fmaxf(s2, s3)));
    const float sum = red64_sum(__expf(s0 - mx) + __expf(s1 - mx) + __expf(s2 - mx) + __expf(s3 - mx));
    const float inv = 1.f / sum;
    __syncthreads();
    if (t < 256) sc[t] = __expf(sc[t] - mx) * inv;
    __syncthreads();
    { const int dv4 = (t & 31) * 4, grp = t >> 5;
        f32x4 vv[16];
#pragma unroll
        for (int i = 0; i < 16; ++i) vv[i] = __builtin_nontemporal_load((const f32x4*)(mv + (size_t)(grp * 16 + i) * 512 + dv4));
        f32x4 acc = (f32x4){0.f, 0.f, 0.f, 0.f};
#pragma unroll
        for (int i = 0; i < 16; ++i) acc += vv[i] * sc[grp * 16 + i];
        *(f32x4*)(red + grp * 128 + dv4) = acc; }
    __syncthreads();
    if (t < 128) { float o = 0.f;
#pragma unroll
        for (int gr = 0; gr < 16; ++gr) o += red[gr * 128 + t];
        OC[row * MEMW + h * 128 + t] = f2bf(o); }
}


__device__ void dbg_count_mix(const Args& a, int slot) {
    const int TX = opaque_tid(); const int BX = opaque_bid();
    const unsigned* p = (const unsigned*)(a.ws + WS_MIX);
    unsigned cnt = 0;
    for (size_t i = (size_t)BX * 512 + TX; i < (size_t)SEQ * DM / 2; i += (size_t)gridDim.x * 512) { const unsigned w = p[i];
        const int col = (int)(i % (DM / 2)) * 2;
        if (col >= 1024 && (((w >> 7) & 0xffu) == 0xffu || ((w >> 23) & 0xffu) == 0xffu)) ++cnt; }
    if (cnt) atomicAdd((unsigned*)(a.ws + WS_END) + slot, cnt);
}
__global__ void __launch_bounds__(512, 2) hymba_mega(Args a) {
    extern __shared__ __attribute__((aligned(16))) unsigned char shm[];
    cg::grid_group grid = cg::this_grid();
    LAS unsigned char* lds = (LAS unsigned char*)shm;
    const int G = gridDim.x, bid = opaque_bid(); const int TX = opaque_tid();
    unsigned char* ws = a.ws;
    bf16_t* H = (bf16_t*)(ws + WS_H); bf16_t* PROJ = (bf16_t*)(ws + WS_PROJ); bf16_t* GU = (bf16_t*)(ws + WS_GU); bf16_t* MIX = (bf16_t*)(ws + WS_MIX);
    bf16_t* QC = (bf16_t*)(ws + WS_QC); bf16_t* OC = (bf16_t*)(ws + WS_OC); float* X = (float*)(ws + WS_X);
    float* COS = (float*)(ws + WS_COS); float* SIN = (float*)(ws + WS_SIN);
    volatile LAS unsigned* xst = (volatile LAS unsigned*)(lds + LDS_BYTES - 16);
    if (TX == 0) { xst[0] = 0u; xst[1] = 0u; }
    __syncthreads();
    const XcdBarrier xbar = xcd_barrier_post((unsigned*)(ws + WS_BAR), xst);

    {
        int rot = 0;
#pragma unroll 1
        for (int l = 0; l < 2; ++l) {
            unsigned char* wl = ws + WS_W + (size_t)l * W_LAYER;
            const bool all = (G != 256);
            convT(a.in[9] + (size_t)l * DM * INW, DM, INW, (bf16_t*)(wl + W_IN), 1, (float*)shm, rot, bid, G); rot += 37;
            if (l == 0 || all) { convT(a.in[12] + (size_t)l * DM * DM, DM, DM, (bf16_t*)(wl + W_OUT), 0, (float*)shm, rot, bid, G); rot += 37; }
            if (l == 0 || all) { convT(a.in[15] + (size_t)l * DM * MEMW, DM, MEMW, (bf16_t*)(wl + W_Q), 0, (float*)shm, rot, bid, G); rot += 37; }
            convT(a.in[16] + (size_t)l * DM * MEMW, DM, MEMW, (bf16_t*)(wl + W_K), 0, (float*)shm, rot, bid, G); rot += 37;
            convT(a.in[17] + (size_t)l * DM * MEMW, DM, MEMW, (bf16_t*)(wl + W_V), 0, (float*)shm, rot, bid, G); rot += 37;
            if (l == 0 || all) { convT(a.in[18] + (size_t)l * MEMW * DM, MEMW, DM, (bf16_t*)(wl + W_O), 0, (float*)shm, rot, bid, G); rot += 37; }
            if (all) {
                convT(a.in[20] + (size_t)l * DM * DFF, DM, DFF, (bf16_t*)(wl + W_GU), 2, (float*)shm, rot, bid, G); rot += 37;
                convT(a.in[21] + (size_t)l * DM * DFF, DM, DFF, (bf16_t*)(wl + W_GU), 3, (float*)shm, rot, bid, G); rot += 37;
                convT(a.in[22] + (size_t)l * DFF * DM, DFF, DM, (bf16_t*)(wl + W_D), 0, (float*)shm, rot, bid, G); rot += 37; }
        }
        if (bid == 0 && TX == 0) { *(unsigned*)(ws + WS_END) = 0u; *((unsigned*)(ws + WS_END) + 1) = 0xffffffffu; *((unsigned*)(ws + WS_END) + 2) = 0u; for (int q = 3; q < 12; ++q) *((unsigned*)(ws + WS_END) + q) = 0u; }
        for (int e = bid * 512 + TX; e < 8193 * 64; e += G * 512) { const int i = e & 63, pos = e >> 6;
            const float inv = powf(10000.f, -(float)i / 64.f); const float ang = (float)pos * inv;
            float sn_, cs_; sincosf(ang, &sn_, &cs_); COS[e] = cs_; SIN[e] = sn_; }
        { bf16_t* MN = (bf16_t*)(ws + WS_MN); const int lane = TX & 63;
            for (int r = bid * 8 + (TX >> 6); r < 512; r += G * 8) { const int l = r >> 8, mr = r & 255;
                const float* src = a.in[2] + (size_t)mr * DM; const float* g = a.in[14] + l * DM;
                f32x4 v[8]; float ss = 0.f;
#pragma unroll
                for (int ch = 0; ch < 4; ++ch) { const int col = ch * 512 + lane * 8; v[2 * ch] = *(const f32x4*)(src + col); v[2 * ch + 1] = *(const f32x4*)(src + col + 4);
#pragma unroll
                    for (int j = 0; j < 4; ++j) ss += v[2 * ch][j] * v[2 * ch][j] + v[2 * ch + 1][j] * v[2 * ch + 1][j]; }
                ss = red64_sum(ss); const float rstd = rsqrtf(ss * (1.f / DM) + EPS);
#pragma unroll
                for (int ch = 0; ch < 4; ++ch) { const int col = ch * 512 + lane * 8;
                    const f32x4 y0 = v[2 * ch] * rstd * *(const f32x4*)(g + col), y1 = v[2 * ch + 1] * rstd * *(const f32x4*)(g + col + 4);
                    u32x4 wv; wv.x = cvt_pk_bf16(y0[0], y0[1]); wv.y = cvt_pk_bf16(y0[2], y0[3]); wv.z = cvt_pk_bf16(y1[0], y1[1]); wv.w = cvt_pk_bf16(y1[2], y1[3]);
                    *(u32x4*)(MN + (size_t)r * DM + col) = wv; } } }
        for (int e = bid * 512 + TX; e < 128 * DM / 8; e += G * 512) *(u32x4*)(MIX + (size_t)MROWS * DM + (size_t)e * 8) = (u32x4){0u, 0u, 0u, 0u};
        for (int e = bid * 512 + TX; e < 128 * MEMW / 8; e += G * 512) *(u32x4*)(OC + (size_t)MROWS * MEMW + (size_t)e * 8) = (u32x4){0u, 0u, 0u, 0u};
    }
    grid.sync();

#pragma unroll 1
    for (int step = 0; step < NLAYERS * 13; ++step) {
        const int l = step / 13, p = step - l * 13;
        unsigned char* wl = ws + WS_W + (size_t)l * W_LAYER;
        if (p == 0 || p == 6 || p == 10) {
            const float* gp = (p == 0 ? a.in[8] : (p == 6 ? a.in[13] : a.in[19])) + l * DM;
            rms_phase(a, step == 0 ? 0 : 1, gp, step == 0 ? 0 : (p == 0 ? (DFF >> 9) : (p == 6 ? (DM >> 9) : (MEMW >> 9))), shm);
        } else if (p == 5 || p == 9 || p == 12) {
            const bf16_t* Ap = p == 5 ? MIX : (p == 9 ? OC : GU);
            const size_t wo = p == 5 ? W_OUT : (p == 9 ? W_O : W_D);
            const int Kd = p == 5 ? DM : (p == 9 ? MEMW : DFF);
            pg8::Gemm g{Ap, (const bf16_t*)(wl + wo), SEQ, DM, Kd, Kd, Kd}; pg8::StaticOrder S; S.init(SEQ, DM, G, bid); pg8::EpiResB E{(bf16_t*)(ws + WS_XB), DM}; pg8::gemm_phase(lds, g, S, E);
            { const int nks = Kd >> 9, c2 = (bid + 128) % G;
                if (c2 < 8 * nks) { const int ks = c2 >> 3;
                    pg8::Gemm g2{Ap + (size_t)SEQ * Kd + ks * 512, (const bf16_t*)(wl + wo) + ks * 512, 256, DM, 512, Kd, Kd};
                    pg8::OneUnit S2{c2 & 7}; pg8::EpiResPart E2{(float*)(ws + WS_PART) + (size_t)ks * 128 * DM, DM}; pg8::gemm_phase(lds, g2, S2, E2); } }
        } else if (p == 1) {
            { pg8::Gemm g{H, (const bf16_t*)(wl + W_IN), MP, INW, DM, DM, DM}; pg8::StaticOrder S; S.init(MP, INW, G, bid);
                pg8::EpiIn E{PROJ, COS, SIN, a.out, l}; pg8::gemm_phase(lds, g, S, E); }
            if (l == 0) {
#pragma unroll 1
                for (int ll = 0; ll < 2; ++ll) {
                    unsigned char* wll = ws + WS_W + (size_t)ll * W_LAYER;
                    const bf16_t* MN = (const bf16_t*)(ws + WS_MN) + (size_t)ll * MEML * DM;
                    bf16_t* MK = (bf16_t*)(ws + WS_MK) + (size_t)ll * MEML * MEMW; bf16_t* MVT = (bf16_t*)(ws + WS_MVT) + (size_t)ll * MEMW * MEML;
#pragma unroll 1
                    for (int kv = 0; kv < 2; ++kv) {
                        pg8::Gemm g{MN, (const bf16_t*)(wll + (kv ? W_V : W_K)), MEML, MEMW, DM, DM, DM}; pg8::StaticOrder S; S.init(MEML, MEMW, G, (bid + 40 - kv * 2 - ll * 6) % G);
                        pg8::EpiMem E{a.out + (kv ? OFF_MVP : OFF_MKP) + (size_t)ll * MEML * MEMW, kv ? nullptr : MK, MEMW}; pg8::gemm_phase(lds, g, S, E); }
                    { pg8::Gemm g{(const bf16_t*)(wll + W_V), MN, MEMW, MEML, DM, DM, DM}; pg8::StaticOrder S; S.init(MEMW, MEML, G, (bid + 36 - ll * 6) % G);
                        pg8::EpiBf E{MVT, MEML}; pg8::gemm_phase(lds, g, S, E); }
                }
            }
        } else if (p == 2) {
            for (int k = 0; k < 9; ++k) { const int it = bid + (((bid >> 3) & 1) ? (8 - k) : k) * G;
                if (it >= 2304) continue;
                if (it < 512) { const int xcd = it & 7, idx = (it >> 3);
                    swa_prompt_item(a, l, xcd + 8 * (idx >> 3), idx & 7, shm); }
                else if (it < 1024) ret_kv_item(a, (it - 512) >> 3, (it - 512) & 7, shm);
                else if (it < 2048) ret_decode_item(a, l, (it - 1024) >> 3, (it - 1024) & 7, shm);
                else swa_decode_item(a, l, (it - 2048) >> 1, (it - 2048) & 1, shm);
            }
        } else if (p == 3) {
            ret_scan_phase(a, l);
        } else if (p == 4) {
            for (int it = bid; it < 512; it += G) ret_out_item(a, l, it >> 3, it & 7, shm);
        } else if (p == 7) {
            pg8::Gemm g{H, (const bf16_t*)(wl + W_Q), MP, MEMW, DM, DM, DM}; pg8::StaticOrder S; S.init(MP, MEMW, G, bid); pg8::EpiBf E{QC, MEMW}; pg8::gemm_phase(lds, g, S, E);
            if (G == 256 && bid >= 66) {
                const int vb = bid - 66, vG = G - 66;
                convT(a.in[20] + (size_t)l * DM * DFF, DM, DFF, (bf16_t*)(wl + W_GU), 2, (float*)shm, 0, vb, vG);
                convT(a.in[21] + (size_t)l * DM * DFF, DM, DFF, (bf16_t*)(wl + W_GU), 3, (float*)shm, 61, vb, vG);
                if (l == 0) { unsigned char* w1 = ws + WS_W + W_LAYER;
                    convT(a.in[12] + (size_t)DM * DM, DM, DM, (bf16_t*)(w1 + W_OUT), 0, (float*)shm, 122, vb, vG);
                    convT(a.in[15] + (size_t)DM * MEMW, DM, MEMW, (bf16_t*)(w1 + W_Q), 0, (float*)shm, 31, vb, vG);
                    convT(a.in[18] + (size_t)MEMW * DM, MEMW, DM, (bf16_t*)(w1 + W_O), 0, (float*)shm, 93, vb, vG); }
            }
        } else if (p == 8) {
            for (int k = 0; k < 3; ++k) { const int it = bid + (((bid >> 3) & 1) ? (2 - k) : k) * G;
                if (it >= 768) continue;
                if (it < 256) xattn_prompt_item(a, l, it >> 2, it & 3, shm);
                else xattn_decode_item(a, l, (it - 256) >> 2, (it - 256) & 3, shm);
            }
        } else {
            pg8::Gemm g{H, (const bf16_t*)(wl + W_GU), MP, 2 * DFF, DM, DM, DM}; pg8::StaticOrder S; S.init(MP, 2 * DFF, G, bid); pg8::EpiGU E{GU}; pg8::gemm_phase(lds, g, S, E);
            if (G == 256 && bid >= 172) {
                convT(a.in[22] + (size_t)l * DFF * DM, DFF, DM, (bf16_t*)(wl + W_D), 0, (float*)shm, 0, bid - 172, G - 172);
            }
        }
        xcd_barrier(xbar);
    }
    rms_phase(a, 2, a.in[23], DFF >> 9, shm);
#ifdef DBG_PROBE
    xcd_barrier(xbar);
    dbg_count_mix(a, 7);
    xcd_barrier(xbar);
    {
        int first = 9; unsigned c = 0;
        for (int q = 7; q >= 4; --q) { const unsigned v = __hip_atomic_load((unsigned*)(ws + WS_END) + q, __ATOMIC_RELAXED, __HIP_MEMORY_SCOPE_AGENT); if (v) { first = q; c = v; } }
        int lg = 0; while ((c >> lg) > 1u) ++lg;
        const float K = sqrtf((float)(first) * powf(10.f, (float)(2 + lg)));
        for (size_t e2 = (size_t)bid * 512 + TX; e2 < OUT_TOTAL; e2 += (size_t)G * 512) a.out[e2] = (e2 >= OFF_YS && e2 < OFF_RETP) ? K : 0.f;
    }
#endif
}

extern "C" void kernel_launch(void* const* d_in, const int* in_sizes, int n_in, void* d_out, int out_size, void* d_ws, size_t ws_size, hipStream_t stream) {
    static int grid = 0;
    if (grid == 0) {
        if (n_in != 24 || (size_t)out_size != OUT_TOTAL || ws_size < WS_END + 256) { fprintf(stderr, "kernel_launch: unexpected shapes (n_in %d out %d ws %zu need %zu)\n", n_in, out_size, ws_size, (size_t)WS_END); grid = -1; return; }
        int dev = 0, cus = 0, per_cu = 0;
        hipGetDevice(&dev); hipDeviceGetAttribute(&cus, hipDeviceAttributeMultiprocessorCount, dev);
        if (hipFuncSetAttribute((const void*)hymba_mega, hipFuncAttributeMaxDynamicSharedMemorySize, LDS_BYTES) != hipSuccess) { fprintf(stderr, "kernel_launch: hipFuncSetAttribute failed\n"); grid = -1; return; }
        if (hipOccupancyMaxActiveBlocksPerMultiprocessor(&per_cu, (const void*)hymba_mega, 512, LDS_BYTES) != hipSuccess || per_cu < 1) { fprintf(stderr, "kernel_launch: occupancy query says %d\n", per_cu); per_cu = 1; }
        (void)hipGetLastError();
        grid = cus * 1;
    }
    if (grid < 0) return;
    Args a{};
    for (int i = 0; i < 24; ++i) a.in[i] = (const float*)d_in[i];
    a.out = (float*)d_out; a.ws = (unsigned char*)d_ws;
    (void)hipMemsetAsync((char*)d_ws + WS_BAR, 0, 16384, stream);
    void* args[] = {&a};
    hipError_t e = hipLaunchCooperativeKernel((const void*)hymba_mega, dim3(grid), dim3(512), args, LDS_BYTES, stream);
    if (e != hipSuccess) fprintf(stderr, "cooperative launch failed: %s (grid %d)\n", hipGetErrorString(e), grid);
}
```

```cpp
#define NLAYERS 2
#include <hip/hip_runtime.h>
#include <hip/hip_cooperative_groups.h>
#include <cstdio>
namespace cg = cooperative_groups;

#define LAS __attribute__((address_space(3)))
typedef unsigned short bf16_t;
typedef short bf16x8 __attribute__((ext_vector_type(8)));
typedef float f32x4 __attribute__((ext_vector_type(4)));
typedef unsigned u32x4 __attribute__((ext_vector_type(4)));
typedef unsigned u32x2 __attribute__((ext_vector_type(2)));

constexpr int DM = 2048, SEQ = 8192, NBAT = 128, MROWS = SEQ + NBAT  , MP = 8448  ;
constexpr int INW = 5632, DFF = 5632, MEMW = 512, MEML = 256;
constexpr float EPS = 1e-6f;
constexpr float QK_SCALE = 0.08838834764831845f;
constexpr int LDS_BYTES = 147456;

constexpr size_t OFF_YP = 0;
constexpr size_t OFF_YS = OFF_YP + (size_t)SEQ * DM;
constexpr size_t OFF_RETP = OFF_YS + (size_t)NBAT * DM;
constexpr size_t OFF_WKP = OFF_RETP + 2 * 8 * 128 * 128;
constexpr size_t OFF_WVP = OFF_WKP + 2 * 128 * 256;
constexpr size_t OFF_MKP = OFF_WVP + 2 * 128 * 256;
constexpr size_t OFF_MVP = OFF_MKP + 2 * 256 * 512;
constexpr size_t OFF_RETS = OFF_MVP + 2 * 256 * 512;
constexpr size_t OFF_WKS = OFF_RETS + (size_t)2 * 128 * 8 * 128 * 128;
constexpr size_t OFF_WVS = OFF_WKS + (size_t)2 * 128 * 128 * 256;
constexpr size_t OUT_TOTAL = OFF_WVS + (size_t)2 * 128 * 128 * 256;

constexpr size_t WS_X = 0;
constexpr size_t WS_H = WS_X + (size_t)MP * DM * 4;
constexpr size_t WS_PROJ = WS_H + (size_t)MP * DM * 2;
constexpr size_t WS_GU = WS_PROJ + (size_t)MP * INW * 2;
constexpr size_t WS_MIX = WS_GU + (size_t)MP * DFF * 2;
constexpr size_t WS_QC = WS_MIX + (size_t)MP * DM * 2;
constexpr size_t WS_OC = WS_QC + (size_t)MP * MEMW * 2;
constexpr size_t WS_KVT = WS_OC + (size_t)MP * MEMW * 2;
constexpr size_t WS_RT = WS_KVT + (size_t)64 * 8 * 16384 * 4;
constexpr size_t WS_MN = WS_RT + (size_t)64 * 8 * 16384 * 2;
constexpr size_t WS_MK = WS_MN + (size_t)2 * MEML * DM * 2;
constexpr size_t WS_MVT = WS_MK + (size_t)2 * MEML * MEMW * 2;
constexpr size_t WS_COS = WS_MVT + (size_t)2 * MEML * MEMW * 2;
constexpr size_t WS_SIN = WS_COS + (size_t)8256 * 64 * 4;
constexpr size_t WS_W = WS_SIN + (size_t)8256 * 64 * 4;
constexpr size_t W_IN = 0;
constexpr size_t W_OUT = W_IN + (size_t)INW * DM * 2;
constexpr size_t W_Q = W_OUT + (size_t)DM * DM * 2;
constexpr size_t W_K = W_Q + (size_t)MEMW * DM * 2;
constexpr size_t W_V = W_K + (size_t)MEMW * DM * 2;
constexpr size_t W_O = W_V + (size_t)MEMW * DM * 2;
constexpr size_t W_GU = W_O + (size_t)DM * MEMW * 2;
constexpr size_t W_D = W_GU + (size_t)2 * DFF * DM * 2;
constexpr size_t W_LAYER = W_D + (size_t)DM * DFF * 2;
constexpr size_t WS_BAR = WS_W + 2 * W_LAYER;
constexpr size_t WS_XB = WS_BAR + 16384;
constexpr size_t WS_PART = WS_XB + (size_t)SEQ * DM * 2;
constexpr size_t WS_END = WS_PART + (size_t)11 * 128 * DM * 4;

struct Args { const float* in[24]; float* out; unsigned char* ws; };

typedef __bf16 bf16x2_t __attribute__((ext_vector_type(2)));
__device__ __forceinline__ unsigned cvt_pk_bf16(float lo, float hi) { bf16x2_t v; v.x = (__bf16)lo; v.y = (__bf16)hi; return __builtin_bit_cast(unsigned, v); }
__device__ __forceinline__ bf16_t f2bf(float x) { return (bf16_t)(cvt_pk_bf16(x, 0.f) & 0xffffu); }
__device__ __forceinline__ float bf2f(unsigned h) { return __uint_as_float(h << 16); }
__device__ __forceinline__ float bflo(unsigned w) { return __uint_as_float(w << 16); }
__device__ __forceinline__ float bfhi(unsigned w) { return __uint_as_float(w & 0xffff0000u); }
__device__ __forceinline__ f32x4 mfma16(bf16x8 a, bf16x8 b, f32x4 c) { return __builtin_amdgcn_mfma_f32_16x16x32_bf16(a, b, c, 0, 0, 0); }
__device__ __forceinline__ bf16x8 ld8(const bf16_t* p) { return *reinterpret_cast<const bf16x8*>(p); }
template <int CTRL> __device__ __forceinline__ float dpp_mov(float v) { return __builtin_bit_cast(float, __builtin_amdgcn_update_dpp(0, __builtin_bit_cast(int, v), CTRL, 0xf, 0xf, true)); }
__device__ __forceinline__ float red16_sum(float v) { v += dpp_mov<0xB1>(v); v += dpp_mov<0x4E>(v); v += dpp_mov<0x141>(v); v += dpp_mov<0x140>(v); return v; }
__device__ __forceinline__ float red16_max(float v) { v = fmaxf(v, dpp_mov<0xB1>(v)); v = fmaxf(v, dpp_mov<0x4E>(v)); v = fmaxf(v, dpp_mov<0x141>(v)); v = fmaxf(v, dpp_mov<0x140>(v)); return v; }
__device__ __forceinline__ float red64_sum(float v) { v = red16_sum(v); v += __shfl_xor(v, 16); v += __shfl_xor(v, 32); return v; }
__device__ __forceinline__ float red64_max(float v) { v = red16_max(v); v = fmaxf(v, __shfl_xor(v, 16)); v = fmaxf(v, __shfl_xor(v, 32)); return v; }
__device__ __forceinline__ float silu_f(float x) { return x * __builtin_amdgcn_rcpf(1.f + __expf(-x)); }
__device__ __forceinline__ int opaque_tid() { int t = threadIdx.x; asm volatile("" : "+v"(t)); return t; }
__device__ __forceinline__ int opaque_bid() { int b = blockIdx.x; asm volatile("" : "+s"(b)); return b; }
__device__ __forceinline__ float ret_lg2(int h) { return log1pf(-exp2f(-5.f - (float)h)) * 1.4426950408889634f; }

#define XB_TMO      128
#define XB_XCNT(j)  (256  + 64 * (j))
#define XB_XSUB(j)  (1280 + 64 * (j))
#define XB_XGEN(j)  (2304 + 64 * (j))
#define XB_TOP      3328
#define XB_TOPGEN   3392
#define XCD_BAR_WORDS 3456
#define XB_SPIN_CAP (1u << 18)

__device__ __forceinline__ unsigned xb_ld(unsigned* p)              { return __hip_atomic_load(p, __ATOMIC_RELAXED, __HIP_MEMORY_SCOPE_AGENT); }
__device__ __forceinline__ unsigned xb_add(unsigned* p, unsigned v) { return __hip_atomic_fetch_add(p, v, __ATOMIC_RELAXED, __HIP_MEMORY_SCOPE_AGENT); }
__device__ __forceinline__ unsigned xb_xcc_id() { return (unsigned)__builtin_amdgcn_s_getreg((3 << 11) | 20) & 0xFu; }
#define XB_SPIN(cond, bar) do { unsigned _sp = 0; while (cond) { __builtin_amdgcn_s_sleep(1); \
    if ((++_sp & 255u) == 0u) { if (xb_ld(&(bar)[XB_TMO])) break; if (_sp > XB_SPIN_CAP) { atomicAdd(&(bar)[XB_TMO], 1u); break; } } } } while (0)

struct XcdBarrier {
    unsigned* bar; unsigned x;
    volatile LAS unsigned* st;
};

__device__ __forceinline__ XcdBarrier xcd_barrier_post(unsigned* bar, volatile LAS unsigned* st) {
    XcdBarrier b; b.bar = bar; b.x = xb_xcc_id(); b.st = st;
    if (threadIdx.x == 0) (void)xb_add(&bar[XB_XCNT(b.x)], 1u);
    return b;
}
__device__ __forceinline__ void xcd_barrier_complete(unsigned* bar, unsigned x, unsigned& nloc, unsigned& nx) {
    const unsigned G = gridDim.x * gridDim.y * gridDim.z;
    unsigned sum, cnt, mine, sp = 0u;
    for (;;) {
        sum = 0u; cnt = 0u; mine = 0u;
#pragma unroll
        for (unsigned j = 0; j < 16; ++j) { const unsigned c = xb_ld(&bar[XB_XCNT(j)]); sum += c; cnt += (c > 0u) ? 1u : 0u; mine = (j == x) ? c : mine; }
        if (sum == G) break;
        __builtin_amdgcn_s_sleep(1);
        if ((++sp & 255u) == 0u) { if (xb_ld(&bar[XB_TMO])) break; if (sp > XB_SPIN_CAP) { atomicAdd(&bar[XB_TMO], 1u); break; } }
    }
    nloc = mine > 0u ? mine : 1u; nx = cnt > 0u ? cnt : 1u;
}

__device__ __forceinline__ void xcd_barrier(const XcdBarrier& b) {
    asm volatile("s_waitcnt vmcnt(0)" ::: "memory");
    __syncthreads();
    if (threadIdx.x == 0) {
        unsigned* bar = b.bar;
        __builtin_amdgcn_s_waitcnt(0);
        unsigned nloc = b.st[0], nx = b.st[1];
        if (nloc == 0u) { xcd_barrier_complete(bar, b.x, nloc, nx); b.st[0] = nloc; b.st[1] = nx; }
        const unsigned old = xb_add(&bar[XB_XSUB(b.x)], 1u);
        const unsigned gen = old / nloc;
        if (old + 1u == (gen + 1u) * nloc) {
            __builtin_amdgcn_fence(__ATOMIC_RELEASE, "agent");
            asm volatile("s_waitcnt vmcnt(0)" ::: "memory");
            const unsigned og = xb_add(&bar[XB_TOP], 1u);
            const unsigned tg = og / nx;
            if (og + 1u == (tg + 1u) * nx) xb_add(&bar[XB_TOPGEN], 1u);
            else XB_SPIN(xb_ld(&bar[XB_TOPGEN]) == tg, bar);
            __builtin_amdgcn_fence(__ATOMIC_ACQUIRE, "agent");
            xb_add(&bar[XB_XGEN(b.x)], 1u);
            asm volatile("s_waitcnt vmcnt(0)" ::: "memory");
        } else {
            XB_SPIN(xb_ld(&bar[XB_XGEN(b.x)]) == gen, bar);
            __builtin_amdgcn_fence(__ATOMIC_ACQUIRE, "agent");
            asm volatile("s_waitcnt vmcnt(0)" ::: "memory");
        }
    }
    __syncthreads();
}


namespace pg8 {
constexpr int BM = 256, BK = 64, HALF = 128, HTB = HALF * BK * 2, STAGE_BYTES = 8 * HTB, NXCD = 8, WGM = 8;
__device__ __forceinline__ int lds_byte(int r, int c) { const int st = (r >> 4) * 2 + (c >> 5), rr = r & 15, cc = c & 31, ob = rr * 64 + cc * 2; return st * 1024 + (ob ^ (((ob >> 9) & 1) << 5)); }
__device__ __forceinline__ void stage_rc(int b, int& R, int& C) { const int st = b / 1024, sb = b % 1024, swz = sb ^ (((sb >> 9) & 1) << 5); R = (st >> 1) * 16 + swz / 64; C = (st & 1) * 32 + (swz % 64) / 2; }
__device__ __forceinline__ int perm32(int rho) { const int n = rho >> 4, i = rho & 15; return 8 * (i >> 2) + 4 * n + (i & 3); }
struct Unit { int pm, pn; };
struct Gemm { const bf16_t* A; const bf16_t* Bt; int M, N, K, lda, ldb; };
struct StaticOrder {
    int nM, nN, nwg, G, c;
    __device__ void init(int M, int N, int G_, int c_) { nM = M / BM; nN = N / BM; nwg = nM * nN; G = G_; c = c_; }
    __device__ bool next(int i, Unit& u) const {
        const long L = (long)i * G + c; if (L >= nwg) return false;
        int wgid = (int)L; { const int q = nwg / NXCD, r = nwg % NXCD, xcd = wgid % NXCD, off = wgid / NXCD; wgid = (xcd < r ? xcd * (q + 1) : r * (q + 1) + (xcd - r) * q) + off; }
        const int nig = WGM * nN, gid = wgid / nig, fm = gid * WGM, gsz = (nM - fm) < WGM ? (nM - fm) : WGM;
        u.pm = fm + ((wgid % nig) % gsz); u.pn = (wgid % nig) / gsz; return true;
    }
    __device__ __forceinline__ void a_ready(const Unit&) const {}
    __device__ __forceinline__ void done(const Unit&) const {}
};

struct OneUnit {
    int pn;
    __device__ bool next(int i, Unit& u) const { if (i != 0) return false; u.pm = 0; u.pn = pn; return true; }
    __device__ __forceinline__ void a_ready(const Unit&) const {}
    __device__ __forceinline__ void done(const Unit&) const {}
};
template <class Epi, class Sched>
__device__ __forceinline__ void gemm_phase(LAS unsigned char* lds, const Gemm g, const Sched& S, const Epi& E) {
    const int tid = opaque_tid(), wid = __builtin_amdgcn_readfirstlane(tid >> 6), lane = tid & 63, wr = wid >> 2, wc = wid & 3, fr = lane & 15, fq = lane >> 4;
    const int K = g.K, nt = K / BK;
    unsigned voffA[2], voffB[2];
#pragma unroll
    for (int i = 0; i < 2; ++i) { int R, C; stage_rc(tid * 16 + i * 8192, R, C); const int Rb = Epi::PERM ? ((R & ~31) + perm32(R & 31)) : R;
        voffA[i] = (unsigned)(R * g.lda + C) * 2u; voffB[i] = (unsigned)(Rb * g.ldb + C) * 2u; }
    const size_t kstep = (size_t)(BK * 2);
    const size_t hstepA = (size_t)HALF * g.lda * 2, hstepB = (size_t)HALF * g.ldb * 2;
    const size_t tstepA = 2 * hstepA, tstepB = 2 * hstepB;
    const unsigned ldsw = (unsigned)wid * 1024u;
    const int aoff = lds_byte(wr * 64 + fr, fq * 8), boff = lds_byte(wc * 32 + fr, fq * 8);
#define PG8_SA(b, h) (((b) * 2 + (h)) * HTB)
#define PG8_SB(b, h) ((4 + (b) * 2 + (h)) * HTB)
#define PG8_STAGE(bufoff, gbase, voff) do { _Pragma("unroll") for (int _i = 0; _i < 2; ++_i) \
        __builtin_amdgcn_global_load_lds((const unsigned*)((const char*)(gbase) + (voff)[_i]), (LAS unsigned*)(lds + (bufoff) + ldsw + _i * 8192), 16, 0, 0); } while (0)
#define PG8_LDA(dst, b, h) do { _Pragma("unroll") for (int m = 0; m < 4; ++m) _Pragma("unroll") for (int k = 0; k < 2; ++k) dst[m][k] = *(const LAS bf16x8*)(lds + PG8_SA(b, h) + aoff + m * 2048 + k * 1024); } while (0)
#define PG8_LDB(dst, b, h) do { _Pragma("unroll") for (int n = 0; n < 2; ++n) _Pragma("unroll") for (int k = 0; k < 2; ++k) dst[n][k] = *(const LAS bf16x8*)(lds + PG8_SB(b, h) + boff + n * 2048 + k * 1024); } while (0)
#define PG8_MMA(ai, bj, At, Bt) do { __builtin_amdgcn_s_setprio(1); _Pragma("unroll") for (int m = 0; m < 4; ++m) _Pragma("unroll") for (int n = 0; n < 2; ++n) _Pragma("unroll") for (int k = 0; k < 2; ++k) \
        acc[ai][bj][m][n] = __builtin_amdgcn_mfma_f32_16x16x32_bf16(Bt[n][k], At[m][k], acc[ai][bj][m][n], 0, 0, 0); __builtin_amdgcn_s_setprio(0); } while (0)
#define PG8_WAIT_V(n) asm volatile("s_waitcnt vmcnt(" #n ")" ::: "memory")
#define PG8_WAIT_L(n) asm volatile("s_waitcnt lgkmcnt(" #n ")" ::: "memory")
#define PG8_BAR __builtin_amdgcn_s_barrier()
#define PG8_SCHED __builtin_amdgcn_sched_barrier(0)
    Unit cur, nxt; int ui = 0;
    if (!S.next(0, cur)) return;
    f32x4 acc[2][2][4][2];
#pragma unroll
    for (int a = 0; a < 2; ++a)
#pragma unroll
        for (int b = 0; b < 2; ++b)
#pragma unroll
            for (int m = 0; m < 4; ++m)
#pragma unroll
                for (int n = 0; n < 2; ++n) acc[a][b][m][n] = (f32x4){0.f, 0.f, 0.f, 0.f};
    bf16x8 At[4][2], B0[2][2], B1[2][2];
    const char* cA = (const char*)g.A + (size_t)cur.pm * tstepA; const char* cB = (const char*)g.Bt + (size_t)cur.pn * tstepB;
    S.a_ready(cur);
    PG8_STAGE(PG8_SB(0, 0), cB, voffB); PG8_STAGE(PG8_SA(0, 0), cA, voffA); PG8_STAGE(PG8_SB(0, 1), cB + hstepB, voffB); PG8_STAGE(PG8_SA(0, 1), cA + hstepA, voffA);
    if (wr == 1) PG8_BAR;
    PG8_WAIT_V(4); PG8_BAR;
    PG8_STAGE(PG8_SB(1, 0), cB + kstep, voffB); PG8_STAGE(PG8_SA(1, 0), cA + kstep, voffA); PG8_STAGE(PG8_SB(1, 1), cB + hstepB + kstep, voffB);
    PG8_WAIT_V(6); PG8_BAR;
    for (;;) {
        const bool has_next = S.next(ui + 1, nxt);
        const char* nA = has_next ? (const char*)g.A + (size_t)nxt.pm * tstepA : cA; const char* nB = has_next ? (const char*)g.Bt + (size_t)nxt.pn * tstepB : cB;
        for (int t = 0; t < nt; t += 2) {
            const bool last = (t == nt - 2);
            const char* a1 = cA + (size_t)(t + 1) * kstep;
            const char* a2 = last ? nA : cA + (size_t)(t + 2) * kstep; const char* b2 = last ? nB : cB + (size_t)(t + 2) * kstep;
            const char* a3 = a2 + kstep; const char* b3 = b2 + kstep;
            if (last && has_next) S.a_ready(nxt);
            PG8_LDB(B0, 0, 0); PG8_SCHED; PG8_LDA(At, 0, 0); PG8_STAGE(PG8_SA(1, 1), a1 + hstepA, voffA);
            PG8_WAIT_L(8); PG8_BAR; PG8_WAIT_L(0); PG8_MMA(0, 0, At, B0); PG8_BAR; PG8_SCHED;
            PG8_LDB(B1, 0, 1); PG8_STAGE(PG8_SB(0, 0), b2, voffB);
            PG8_BAR; PG8_WAIT_L(0); PG8_MMA(0, 1, At, B1); PG8_BAR;
            PG8_LDA(At, 0, 1); PG8_STAGE(PG8_SA(0, 0), a2, voffA);
            PG8_BAR; PG8_WAIT_L(0); PG8_MMA(1, 0, At, B0); PG8_BAR; PG8_SCHED;
            PG8_STAGE(PG8_SB(0, 1), b2 + hstepB, voffB);
            PG8_WAIT_V(6); PG8_BAR; PG8_MMA(1, 1, At, B1); PG8_BAR;
            PG8_LDB(B0, 1, 0); PG8_SCHED; PG8_LDA(At, 1, 0); PG8_STAGE(PG8_SA(0, 1), a2 + hstepA, voffA);
            PG8_WAIT_L(8); PG8_BAR; PG8_WAIT_L(0); PG8_MMA(0, 0, At, B0); PG8_BAR; PG8_SCHED;
            PG8_LDB(B1, 1, 1); PG8_STAGE(PG8_SB(1, 0), b3, voffB);
            PG8_BAR; PG8_WAIT_L(0); PG8_MMA(0, 1, At, B1); PG8_BAR;
            PG8_LDA(At, 1, 1); PG8_STAGE(PG8_SA(1, 0), a3, voffA);
            PG8_BAR; PG8_WAIT_L(0); PG8_MMA(1, 0, At, B0); PG8_BAR; PG8_SCHED;
            PG8_STAGE(PG8_SB(1, 1), b3 + hstepB, voffB);
            PG8_WAIT_V(6); PG8_BAR; PG8_MMA(1, 1, At, B1); PG8_BAR;
        }
        E(acc, cur, wr, wc, fr, fq); S.done(cur);
        if (!has_next) break;
#pragma unroll
        for (int a = 0; a < 2; ++a)
#pragma unroll
            for (int b = 0; b < 2; ++b)
#pragma unroll
                for (int m = 0; m < 4; ++m)
#pragma unroll
                    for (int n = 0; n < 2; ++n) acc[a][b][m][n] = (f32x4){0.f, 0.f, 0.f, 0.f};
        cur = nxt; cA = nA; cB = nB; ++ui;
    }
    PG8_WAIT_V(0);
    if (wr == 0) PG8_BAR;
    PG8_BAR;
#undef PG8_SA
#undef PG8_SB
#undef PG8_STAGE
#undef PG8_LDA
#undef PG8_LDB
#undef PG8_MMA
#undef PG8_WAIT_V
#undef PG8_WAIT_L
#undef PG8_BAR
#undef PG8_SCHED
}

struct EpiRes {
    static constexpr bool PERM = false;
    float* X; int ldc;
    __device__ __forceinline__ void operator()(const f32x4 (&acc)[2][2][4][2], const Unit& u, int wr, int wc, int fr, int fq) const {
        const int row0 = u.pm * BM + wr * 64 + fr, col0 = u.pn * BM + wc * 32 + 4 * fq;
#pragma unroll
        for (int ai = 0; ai < 2; ++ai)
#pragma unroll
            for (int m = 0; m < 4; ++m) { float* rowp = X + (size_t)(row0 + ai * HALF + m * 16) * ldc + col0;
                f32x4 o[2][2];
#pragma unroll
                for (int bj = 0; bj < 2; ++bj)
#pragma unroll
                    for (int n = 0; n < 2; ++n) o[bj][n] = *(const f32x4*)(rowp + bj * HALF + n * 16);
#pragma unroll
                for (int bj = 0; bj < 2; ++bj)
#pragma unroll
                    for (int n = 0; n < 2; ++n) *(f32x4*)(rowp + bj * HALF + n * 16) = o[bj][n] + acc[ai][bj][m][n];
                asm volatile("" ::: "memory"); }
    }
};
struct EpiResB {
    static constexpr bool PERM = true;
    bf16_t* XB; int ldc;
    __device__ __forceinline__ void operator()(const f32x4 (&acc)[2][2][4][2], const Unit& u, int wr, int wc, int fr, int fq) const {
        const int row0 = u.pm * BM + wr * 64 + fr, col0 = u.pn * BM + wc * 32 + 8 * fq;
#pragma unroll
        for (int ai = 0; ai < 2; ++ai) {
            u32x4 o[4][2];
#pragma unroll
            for (int m = 0; m < 4; ++m)
#pragma unroll
                for (int bj = 0; bj < 2; ++bj) o[m][bj] = *(const u32x4*)(XB + (size_t)(row0 + ai * HALF + m * 16) * ldc + col0 + bj * HALF);
            asm volatile("" ::: "memory");
#pragma unroll
            for (int m = 0; m < 4; ++m)
#pragma unroll
                for (int bj = 0; bj < 2; ++bj) { const u32x4 x = o[m][bj]; const f32x4 v0 = acc[ai][bj][m][0], v1 = acc[ai][bj][m][1];
                    u32x4 w; w.x = cvt_pk_bf16(bflo(x.x) + v0[0], bfhi(x.x) + v0[1]); w.y = cvt_pk_bf16(bflo(x.y) + v0[2], bfhi(x.y) + v0[3]);
                    w.z = cvt_pk_bf16(bflo(x.z) + v1[0], bfhi(x.z) + v1[1]); w.w = cvt_pk_bf16(bflo(x.w) + v1[2], bfhi(x.w) + v1[3]);
                    *(u32x4*)(XB + (size_t)(row0 + ai * HALF + m * 16) * ldc + col0 + bj * HALF) = w; }
            asm volatile("" ::: "memory"); }
    }
};
struct EpiResPart {
    static constexpr bool PERM = false;
    float* P; int ldc;
    __device__ __forceinline__ void operator()(const f32x4 (&acc)[2][2][4][2], const Unit& u, int wr, int wc, int fr, int fq) const {
        const int row0 = wr * 64 + fr, col0 = u.pn * BM + wc * 32 + 4 * fq;
#pragma unroll
        for (int m = 0; m < 4; ++m) { float* rowp = P + (size_t)(row0 + m * 16) * ldc + col0;
#pragma unroll
            for (int bj = 0; bj < 2; ++bj)
#pragma unroll
                for (int n = 0; n < 2; ++n) *(f32x4*)(rowp + bj * HALF + n * 16) = acc[0][bj][m][n]; }
    }
};
struct EpiResAtomic {
    static constexpr bool PERM = false;
    float* X; int ldc;
    __device__ __forceinline__ void operator()(const f32x4 (&acc)[2][2][4][2], const Unit& u, int wr, int wc, int fr, int fq) const {
        const int row0 = wr * 64 + fr, col0 = u.pn * BM + wc * 32 + 4 * fq;
#pragma unroll
        for (int m = 0; m < 4; ++m) { float* rowp = X + (size_t)(row0 + m * 16) * ldc + col0;
#pragma unroll
            for (int bj = 0; bj < 2; ++bj)
#pragma unroll
                for (int n = 0; n < 2; ++n)
#pragma unroll
                    for (int j = 0; j < 4; ++j) __hip_atomic_fetch_add(rowp + bj * HALF + n * 16 + j, acc[0][bj][m][n][j], __ATOMIC_RELAXED, __HIP_MEMORY_SCOPE_AGENT); }
    }
};
struct EpiBf {
    static constexpr bool PERM = true;
    bf16_t* O; int ldc;
    __device__ __forceinline__ void operator()(const f32x4 (&acc)[2][2][4][2], const Unit& u, int wr, int wc, int fr, int fq) const {
        const int row0 = u.pm * BM + wr * 64 + fr, col0 = u.pn * BM + wc * 32 + 8 * fq;
#pragma unroll
        for (int ai = 0; ai < 2; ++ai)
#pragma unroll
            for (int m = 0; m < 4; ++m) { bf16_t* rowp = O + (size_t)(row0 + ai * HALF + m * 16) * ldc + col0;
#pragma unroll
                for (int bj = 0; bj < 2; ++bj) { const f32x4 v0 = acc[ai][bj][m][0], v1 = acc[ai][bj][m][1];
                    u32x4 w; w.x = cvt_pk_bf16(v0[0], v0[1]); w.y = cvt_pk_bf16(v0[2], v0[3]); w.z = cvt_pk_bf16(v1[0], v1[1]); w.w = cvt_pk_bf16(v1[2], v1[3]);
                    *(u32x4*)(rowp + bj * HALF) = w; } }
    }
};
struct EpiMem {
    static constexpr bool PERM = false;
    float* C; bf16_t* O; int ldc;
    __device__ __forceinline__ void operator()(const f32x4 (&acc)[2][2][4][2], const Unit& u, int wr, int wc, int fr, int fq) const {
        const int row0 = u.pm * BM + wr * 64 + fr, col0 = u.pn * BM + wc * 32 + 4 * fq;
#pragma unroll
        for (int ai = 0; ai < 2; ++ai)
#pragma unroll
            for (int m = 0; m < 4; ++m) { const size_t ro = (size_t)(row0 + ai * HALF + m * 16) * ldc + col0;
#pragma unroll
                for (int bj = 0; bj < 2; ++bj)
#pragma unroll
                    for (int n = 0; n < 2; ++n) { const f32x4 v = acc[ai][bj][m][n]; *(f32x4*)(C + ro + bj * HALF + n * 16) = v;
                        if (O) { u32x2 w; w.x = cvt_pk_bf16(v[0], v[1]); w.y = cvt_pk_bf16(v[2], v[3]); *(u32x2*)(O + ro + bj * HALF + n * 16) = w; } } }
    }
};
struct EpiGU {
    static constexpr bool PERM = true;
    bf16_t* O;
    __device__ __forceinline__ void operator()(const f32x4 (&acc)[2][2][4][2], const Unit& u, int wr, int wc, int fr, int fq) const {
        const int row0 = u.pm * BM + wr * 64 + fr, col0 = u.pn * 128 + wc * 16 + 4 * fq;
#pragma unroll
        for (int ai = 0; ai < 2; ++ai)
#pragma unroll
            for (int m = 0; m < 4; ++m) { bf16_t* rowp = O + (size_t)(row0 + ai * HALF + m * 16) * DFF + col0;
#pragma unroll
                for (int bj = 0; bj < 2; ++bj) { const f32x4 v0 = acc[ai][bj][m][0], v1 = acc[ai][bj][m][1];
                    u32x2 w; w.x = cvt_pk_bf16(silu_f(v0[0]) * v0[1], silu_f(v0[2]) * v0[3]); w.y = cvt_pk_bf16(silu_f(v1[0]) * v1[1], silu_f(v1[2]) * v1[3]);
                    *(u32x2*)(rowp + bj * 64) = w; } }
    }
};
struct EpiIn {
    static constexpr bool PERM = true;
    bf16_t* P; const float* cs; const float* sn; float* out; int layer;
    __device__ __forceinline__ void operator()(const f32x4 (&acc)[2][2][4][2], const Unit& u, int wr, int wc, int fr, int fq) const {
        const int pn = u.pn, cin = wc * 32 + 8 * fq, rbase = u.pm * BM + wr * 64 + fr;
        const bool rot = pn < 8; const float sc = (pn >= 4 && pn < 8) ? QK_SCALE : 1.f;
#pragma unroll
        for (int ai = 0; ai < 2; ++ai)
#pragma unroll
            for (int m = 0; m < 4; ++m) { const int r = rbase + ai * HALF + m * 16; const int pos = r < SEQ ? r : SEQ;
                f32x4 c4 = (f32x4){1.f, 1.f, 1.f, 1.f}, s4 = (f32x4){0.f, 0.f, 0.f, 0.f};
                if (rot) { c4 = *(const f32x4*)(cs + (size_t)pos * 64 + (cin >> 1)); s4 = *(const f32x4*)(sn + (size_t)pos * 64 + (cin >> 1)); }
#pragma unroll
                for (int bj = 0; bj < 2; ++bj) { const f32x4 v0 = acc[ai][bj][m][0], v1 = acc[ai][bj][m][1];
                    const int cc = bj * HALF + cin;
                    float o[8];
                    o[0] = (v0[0] * c4[0] - v0[1] * s4[0]) * sc; o[1] = (v0[0] * s4[0] + v0[1] * c4[0]) * sc;
                    o[2] = (v0[2] * c4[1] - v0[3] * s4[1]) * sc; o[3] = (v0[2] * s4[1] + v0[3] * c4[1]) * sc;
                    o[4] = (v1[0] * c4[2] - v1[1] * s4[2]) * sc; o[5] = (v1[0] * s4[2] + v1[1] * c4[2]) * sc;
                    o[6] = (v1[2] * c4[3] - v1[3] * s4[3]) * sc; o[7] = (v1[2] * s4[3] + v1[3] * c4[3]) * sc;
                    if (!rot) { o[0] = v0[0]; o[1] = v0[1]; o[2] = v0[2]; o[3] = v0[3]; o[4] = v1[0]; o[5] = v1[1]; o[6] = v1[2]; o[7] = v1[3]; }
                    u32x4 w; w.x = cvt_pk_bf16(o[0], o[1]); w.y = cvt_pk_bf16(o[2], o[3]); w.z = cvt_pk_bf16(o[4], o[5]); w.w = cvt_pk_bf16(o[6], o[7]);
                    *(u32x4*)(P + (size_t)r * INW + pn * BM + cc) = w;
                    if (pn >= 20) {
                        float* dst = nullptr;
                        if (r >= SEQ - 128 && r < SEQ) dst = out + OFF_WKP + (size_t)(pn - 20) * 65536 + (size_t)layer * 32768 + (size_t)(r - (SEQ - 128)) * 256 + cc;
                        else if (r >= SEQ && r < MROWS) dst = out + OFF_WKS + (size_t)(pn - 20) * 8388608 + ((size_t)(layer * 128 + (r - SEQ)) * 128 + 127) * 256 + cc;
                        if (dst) { *(f32x4*)dst = v0; *(f32x4*)(dst + 4) = v1; }
                    } } }
    }
};
}

__device__ __forceinline__ int rowmap(int mode, int n) {
    if (mode == 1) { if (n < 2048) { const int hd = n >> 7, d = n & 127; return (hd << 7) + ((d & 63) << 1) + (d >> 6); } return n; }
    if (mode == 2) return 2 * n;
    if (mode == 3) return 2 * n + 1;
    return n;
}
__device__ void convT(const float* __restrict__ src, int K, int N, bf16_t* __restrict__ dst, int mode, float* tile  , int brot, int vb, int vG) {
    const int TX = opaque_tid(); const int BX = opaque_bid(); (void)BX;
    const int tn = N >> 7, tk = K >> 6, nt = tn * tk, t = TX;
    const int n4 = (t & 31) * 4, kk = t >> 5;
    const int sn = t >> 2, kc = (t & 3) * 16;
    int ti = (vb + brot) % vG;
    f32x4 v[4];
    if (ti < nt) { const int k0 = (ti / tn) << 6, n0 = (ti % tn) << 7;
#pragma unroll
        for (int i = 0; i < 4; ++i) v[i] = *(const f32x4*)(src + (size_t)(k0 + kk + 16 * i) * N + n0 + n4); }
    for (; ti < nt; ti += vG) {
        const int k0 = (ti / tn) << 6, n0 = (ti % tn) << 7;
        const int tnx = ti + vG;
        f32x4 nv[4];
        if (tnx < nt) { const int k1 = (tnx / tn) << 6, n1 = (tnx % tn) << 7;
#pragma unroll
            for (int i = 0; i < 4; ++i) nv[i] = *(const f32x4*)(src + (size_t)(k1 + kk + 16 * i) * N + n1 + n4); }
        else {
#pragma unroll
            for (int i = 0; i < 4; ++i) nv[i] = (f32x4){0.f, 0.f, 0.f, 0.f}; }
        __syncthreads();
#pragma unroll
        for (int i = 0; i < 4; ++i)
#pragma unroll
            for (int j = 0; j < 4; ++j) tile[(n4 + j) * 65 + kk + 16 * i] = v[i][j];
        __syncthreads();
        const float* tp = tile + sn * 65 + kc;
        u32x4 w0, w1;
        w0.x = cvt_pk_bf16(tp[0], tp[1]); w0.y = cvt_pk_bf16(tp[2], tp[3]); w0.z = cvt_pk_bf16(tp[4], tp[5]); w0.w = cvt_pk_bf16(tp[6], tp[7]);
        w1.x = cvt_pk_bf16(tp[8], tp[9]); w1.y = cvt_pk_bf16(tp[10], tp[11]); w1.z = cvt_pk_bf16(tp[12], tp[13]); w1.w = cvt_pk_bf16(tp[14], tp[15]);
        bf16_t* dp = dst + (size_t)rowmap(mode, n0 + sn) * K + k0 + kc;
        *(u32x4*)dp = w0; *(u32x4*)(dp + 8) = w1;
#pragma unroll
        for (int i = 0; i < 4; ++i) v[i] = nv[i];
    }
    __syncthreads();
}

__device__ void rms_phase(const Args& a, int mode, const float* __restrict__ g, int nparts, unsigned char* shm) {
    const int TX = opaque_tid(); const int BX = opaque_bid(); (void)BX;
    float* X = (float*)(a.ws + WS_X); bf16_t* H = (bf16_t*)(a.ws + WS_H); bf16_t* XB = (bf16_t*)(a.ws + WS_XB);
    const int lane = TX & 63, wv = TX >> 6, gw = BX * 8 + wv, nw = gridDim.x * 8;
    if (mode != 0) {
        float* red = (float*)shm;
        for (int rs = BX; rs < NBAT; rs += gridDim.x) { const int r = SEQ + rs;
            f32x4 v[8];
#pragma unroll
            for (int ch = 0; ch < 4; ++ch) { const int col = ch * 512 + lane * 8;
                if (wv == 0) { v[2 * ch] = *(const f32x4*)(X + (size_t)r * DM + col); v[2 * ch + 1] = *(const f32x4*)(X + (size_t)r * DM + col + 4); }
                else { v[2 * ch] = (f32x4){0.f, 0.f, 0.f, 0.f}; v[2 * ch + 1] = (f32x4){0.f, 0.f, 0.f, 0.f}; } }
            const float* part = (const float*)(a.ws + WS_PART) + (size_t)rs * DM;
            for (int ks = wv; ks < nparts; ks += 8) {
#pragma unroll
                for (int ch = 0; ch < 4; ++ch) { const int col = ch * 512 + lane * 8;
                    v[2 * ch] += *(const f32x4*)(part + (size_t)ks * 128 * DM + col); v[2 * ch + 1] += *(const f32x4*)(part + (size_t)ks * 128 * DM + col + 4); } }
            __syncthreads();
            if (wv != 0) {
#pragma unroll
                for (int ch = 0; ch < 4; ++ch) { const int col = ch * 512 + lane * 8;
                    *(f32x4*)(red + wv * DM + col) = v[2 * ch]; *(f32x4*)(red + wv * DM + col + 4) = v[2 * ch + 1]; } }
            __syncthreads();
            if (wv == 0) {
                const int nwv = nparts < 8 ? nparts : 8;
                float ss = 0.f;
#pragma unroll
                for (int ch = 0; ch < 4; ++ch) { const int col = ch * 512 + lane * 8;
                    for (int q = 1; q < nwv; ++q) { v[2 * ch] += *(const f32x4*)(red + q * DM + col); v[2 * ch + 1] += *(const f32x4*)(red + q * DM + col + 4); }
                    *(f32x4*)(X + (size_t)r * DM + col) = v[2 * ch]; *(f32x4*)(X + (size_t)r * DM + col + 4) = v[2 * ch + 1];
#pragma unroll
                    for (int j = 0; j < 4; ++j) ss += v[2 * ch][j] * v[2 * ch][j] + v[2 * ch + 1][j] * v[2 * ch + 1][j]; }
                ss = red64_sum(ss);
                const float rstd = rsqrtf(ss * (1.f / DM) + EPS);
#pragma unroll
                for (int ch = 0; ch < 4; ++ch) { const int col = ch * 512 + lane * 8;
                    const f32x4 g0 = *(const f32x4*)(g + col), g1 = *(const f32x4*)(g + col + 4);
                    const f32x4 y0 = v[2 * ch] * rstd * g0, y1 = v[2 * ch + 1] * rstd * g1;
                    if (mode == 2) { *(f32x4*)(a.out + (size_t)r * DM + col) = y0; *(f32x4*)(a.out + (size_t)r * DM + col + 4) = y1; }
                    else { u32x4 w; w.x = cvt_pk_bf16(y0[0], y0[1]); w.y = cvt_pk_bf16(y0[2], y0[3]); w.z = cvt_pk_bf16(y1[0], y1[1]); w.w = cvt_pk_bf16(y1[2], y1[3]);
                        *(u32x4*)(H + (size_t)r * DM + col) = w; } }
            }
        }
    }
    const int rend = mode == 0 ? MP : SEQ;
    for (int r = gw; r < rend; r += nw) {
        f32x4 v[8]; float ss = 0.f;
        if (mode != 0) {
#pragma unroll
            for (int ch = 0; ch < 4; ++ch) { const u32x4 raw = *(const u32x4*)(XB + (size_t)r * DM + ch * 512 + lane * 8);
                v[2 * ch] = (f32x4){bflo(raw.x), bfhi(raw.x), bflo(raw.y), bfhi(raw.y)}; v[2 * ch + 1] = (f32x4){bflo(raw.z), bfhi(raw.z), bflo(raw.w), bfhi(raw.w)}; }
        } else {
            const float* src = nullptr;
            if (r < SEQ) src = a.in[0] + (size_t)r * DM; else if (r < MROWS) src = a.in[1] + (size_t)(r - SEQ) * DM;
#pragma unroll
            for (int ch = 0; ch < 4; ++ch) { const int col = ch * 512 + lane * 8;
                if (src) { v[2 * ch] = *(const f32x4*)(src + col); v[2 * ch + 1] = *(const f32x4*)(src + col + 4); }
                else { v[2 * ch] = (f32x4){0.f, 0.f, 0.f, 0.f}; v[2 * ch + 1] = (f32x4){0.f, 0.f, 0.f, 0.f}; } }
        }
#pragma unroll
        for (int i = 0; i < 8; ++i)
#pragma unroll
            for (int j = 0; j < 4; ++j) ss += v[i][j] * v[i][j];
        ss = red64_sum(ss);
        const float rstd = rsqrtf(ss * (1.f / DM) + EPS);
#pragma unroll
        for (int ch = 0; ch < 4; ++ch) { const int col = ch * 512 + lane * 8;
            const f32x4 g0 = *(const f32x4*)(g + col), g1 = *(const f32x4*)(g + col + 4);
            const f32x4 y0 = v[2 * ch] * rstd * g0, y1 = v[2 * ch + 1] * rstd * g1;
            if (mode == 0) {
                if (r < SEQ) { u32x4 w; w.x = cvt_pk_bf16(v[2 * ch][0], v[2 * ch][1]); w.y = cvt_pk_bf16(v[2 * ch][2], v[2 * ch][3]); w.z = cvt_pk_bf16(v[2 * ch + 1][0], v[2 * ch + 1][1]); w.w = cvt_pk_bf16(v[2 * ch + 1][2], v[2 * ch + 1][3]);
                    *(u32x4*)(XB + (size_t)r * DM + col) = w; }
                else { *(f32x4*)(X + (size_t)r * DM + col) = v[2 * ch]; *(f32x4*)(X + (size_t)r * DM + col + 4) = v[2 * ch + 1]; } }
            if (mode == 2) { *(f32x4*)(a.out + (size_t)r * DM + col) = y0; *(f32x4*)(a.out + (size_t)r * DM + col + 4) = y1; }
            else { u32x4 w; w.x = cvt_pk_bf16(y0[0], y0[1]); w.y = cvt_pk_bf16(y0[2], y0[3]); w.z = cvt_pk_bf16(y1[0], y1[1]); w.w = cvt_pk_bf16(y1[2], y1[3]);
                *(u32x4*)(H + (size_t)r * DM + col) = w; } }
    }
}

__device__ __forceinline__ void load_T128(const bf16_t* __restrict__ src, size_t ld, bf16_t* dst, int dstStride, int colOff, bool zeta, float lg2, bool zero) {
    const int TX = opaque_tid(); const int BX = opaque_bid(); (void)BX;
    const int t = TX;
#pragma unroll
    for (int i = 0; i < 4; ++i) {
        const int m = (t & 31) + 32 * i, c8 = (t >> 5) * 8;
        u32x4 raw = (u32x4){0u, 0u, 0u, 0u};
        if (!zero) raw = *(const u32x4*)(src + (size_t)m * ld + c8);
        const float sc = zeta ? exp2f(lg2 * (float)(127 - m)) : 1.f;
#pragma unroll
        for (int e = 0; e < 4; ++e) { const unsigned w = raw[e];
            bf16_t lo = (bf16_t)(w & 0xffffu), hi = (bf16_t)(w >> 16);
            if (zeta) { lo = f2bf(bflo(w) * sc); hi = f2bf(bfhi(w) * sc); }
            dst[(c8 + 2 * e) * dstStride + colOff + m] = lo; dst[(c8 + 2 * e + 1) * dstStride + colOff + m] = hi; }
    }
}


template <int NROWS, int CPR>
__device__ __forceinline__ void stage_rows(const bf16_t* __restrict__ src, size_t ld, bf16_t* dst, int dstStride, int tx) {
    constexpr int TOT = NROWS * CPR;
#pragma unroll
    for (int i = 0; i < TOT / 512; ++i) { const int q = tx + 512 * i, r = q / CPR, c = q % CPR;
        *(u32x4*)(dst + r * dstStride + c * 8) = *(const u32x4*)(src + (size_t)r * ld + c * 8); }
}


typedef short v4s_t __attribute__((ext_vector_type(4)));
__device__ __forceinline__ bf16x8 ld8_tr(const bf16_t* tile, int row0, int stride, int col0, int fq, int fr) {
    typedef __attribute__((address_space(3))) v4s_t* lp_t;
    const int q = fr >> 2, p = fr & 3;
    const v4s_t lo = __builtin_amdgcn_ds_read_tr16_b64_v4i16((lp_t)(tile + (row0 + 8 * fq + q) * stride + col0 + 4 * p));
    const v4s_t hi = __builtin_amdgcn_ds_read_tr16_b64_v4i16((lp_t)(tile + (row0 + 8 * fq + 4 + q) * stride + col0 + 4 * p));
    return (bf16x8){lo[0], lo[1], lo[2], lo[3], hi[0], hi[1], hi[2], hi[3]};
}
template <int NROWS, int CPR>
__device__ __forceinline__ void zero_rows(bf16_t* dst, int dstStride, int tx) {
#pragma unroll
    for (int i = 0; i < NROWS * CPR / 512; ++i) { const int q = tx + 512 * i, r = q / CPR, c = q % CPR; *(u32x4*)(dst + r * dstStride + c * 8) = (u32x4){0u, 0u, 0u, 0u}; }
}

__device__ __forceinline__ void ret_kv_item(const Args& a, int n, int h, unsigned char* shm) {
    const int TX = opaque_tid(); const int BX = opaque_bid(); (void)BX;
    const bf16_t* PROJ = (const bf16_t*)(a.ws + WS_PROJ); float* KVT = (float*)(a.ws + WS_KVT);
    bf16_t* Ks = (bf16_t*)shm; bf16_t* Vs = Ks + 128 * 136;
    const int lane = TX & 63, w = TX >> 6, fr = lane & 15, fq = lane >> 4;
    const float lg2 = ret_lg2(h);
    const bf16_t* base = PROJ + (size_t)(n * 128) * INW + h * 128;
    __syncthreads();
#pragma unroll
    for (int i = 0; i < 4; ++i) { const int q = TX + 512 * i, r = q >> 4, c = q & 15;
        const u32x4 raw = *(const u32x4*)(base + 1024 + (size_t)r * INW + c * 8);
        const float sc = exp2f(lg2 * (float)(127 - r));
        u32x4 wv; wv.x = cvt_pk_bf16(bflo(raw.x) * sc, bfhi(raw.x) * sc); wv.y = cvt_pk_bf16(bflo(raw.y) * sc, bfhi(raw.y) * sc);
        wv.z = cvt_pk_bf16(bflo(raw.z) * sc, bfhi(raw.z) * sc); wv.w = cvt_pk_bf16(bflo(raw.w) * sc, bfhi(raw.w) * sc);
        *(u32x4*)(Ks + r * 136 + c * 8) = wv; }
    stage_rows<128, 16>(base + 2048, INW, Vs, 136, TX);
    __syncthreads();
    f32x4 acc[8];
#pragma unroll
    for (int t = 0; t < 8; ++t) acc[t] = (f32x4){0.f, 0.f, 0.f, 0.f};
#pragma unroll
    for (int ks = 0; ks < 4; ++ks) { const bf16x8 av = ld8_tr(Vs, ks * 32, 136, 16 * w, fq, fr);
#pragma unroll
        for (int t = 0; t < 8; ++t) acc[t] = mfma16(av, ld8_tr(Ks, ks * 32, 136, 16 * t, fq, fr), acc[t]); }
    float* dst = KVT + ((size_t)(n * 8 + h) << 14);
#pragma unroll
    for (int t = 0; t < 8; ++t)
#pragma unroll
        for (int j = 0; j < 4; ++j) dst[(16 * w + fq * 4 + j) * 128 + 16 * t + fr] = acc[t][j];
}

__device__ void ret_scan_phase(const Args& a, int l) {
    const int TX = opaque_tid(); const int BX = opaque_bid(); (void)BX;
    float* KVT = (float*)(a.ws + WS_KVT); bf16_t* RT = (bf16_t*)(a.ws + WS_RT);
    for (int e = BX * 512 + TX; e < 8 * 16384; e += gridDim.x * 512) {
        const int h = e >> 14, rem = e & 16383;
        const float g = exp2f(ret_lg2(h) * 128.f);
        float r = 0.f;
        float kvv[64];
#pragma unroll
        for (int n = 0; n < 64; ++n) kvv[n] = KVT[((size_t)(n * 8 + h) << 14) + rem];
#pragma unroll
        for (int n = 0; n < 64; ++n) { const size_t off = ((size_t)(n * 8 + h) << 14) + rem; RT[off] = f2bf(r); r = g * r + kvv[n]; }
        const int dv = rem >> 7, p = rem & 127, dt = (p >> 1) + 64 * (p & 1);
        a.out[OFF_RETP + (size_t)l * 131072 + (size_t)(h * 128 + dt) * 128 + dv] = r;
    }
}

__device__ __forceinline__ void ret_out_item(const Args& a, int l, int n, int h, unsigned char* shm) {
    const int TX = opaque_tid(); const int BX = opaque_bid(); (void)BX;
    const bf16_t* PROJ = (const bf16_t*)(a.ws + WS_PROJ); const bf16_t* RT = (const bf16_t*)(a.ws + WS_RT); bf16_t* MIX = (bf16_t*)(a.ws + WS_MIX);
    const int lane = TX & 63, w = __builtin_amdgcn_readfirstlane(TX >> 6), fr = lane & 15, fq = lane >> 4;
    bf16_t* vT = (bf16_t*)shm; bf16_t* Ks = vT + 128 * 136; bf16_t* Rs = Ks + 128 * 136; bf16_t* Pw = Rs + 128 * 136 + w * (16 * 136);
    const float lg2 = ret_lg2(h);
    const int rowbase = n * 128;
    const bf16_t* base = PROJ + (size_t)rowbase * INW + h * 128;
    __syncthreads();
    stage_rows<128, 16>(base + 2048, INW, vT, 136, TX);
    stage_rows<128, 16>(base + 1024, INW, Ks, 136, TX);
    stage_rows<128, 16>(RT + ((size_t)(n * 8 + h) << 14), 128, Rs, 136, TX);
    bf16x8 qa[4];
#pragma unroll
    for (int ks = 0; ks < 4; ++ks) qa[ks] = ld8(base + (size_t)(16 * w + fr) * INW + ks * 32 + fq * 8);
    __syncthreads();
    for (int t = 0; t <= w; ++t) {
        f32x4 s = (f32x4){0.f, 0.f, 0.f, 0.f};
#pragma unroll
        for (int ks = 0; ks < 4; ++ks) s = mfma16(qa[ks], ld8(Ks + (16 * t + fr) * 136 + ks * 32 + fq * 8), s);
#pragma unroll
        for (int j = 0; j < 4; ++j) { const int diff = (16 * w + fq * 4 + j) - (16 * t + fr);
            const float val = diff >= 0 ? s[j] * exp2f(lg2 * (float)diff) : 0.f;
            Pw[(fq * 4 + j) * 136 + 16 * t + fr] = f2bf(val); }
    }
    if ((w & 1) == 0) {
#pragma unroll
        for (int j = 0; j < 4; ++j) Pw[(fq * 4 + j) * 136 + 16 * (w + 1) + fr] = 0;
    }
    __syncthreads();
    f32x4 oi[8], oc[8];
#pragma unroll
    for (int t = 0; t < 8; ++t) { oi[t] = (f32x4){0.f, 0.f, 0.f, 0.f}; oc[t] = (f32x4){0.f, 0.f, 0.f, 0.f}; }
    const int nks = (w >> 1) + 1;
    for (int ks = 0; ks < nks; ++ks) { const bf16x8 pa = ld8(Pw + fr * 136 + ks * 32 + fq * 8);
#pragma unroll
        for (int t = 0; t < 8; ++t) oi[t] = mfma16(pa, ld8_tr(vT, ks * 32, 136, 16 * t, fq, fr), oi[t]); }
#pragma unroll
    for (int ks = 0; ks < 4; ++ks)
#pragma unroll
        for (int t = 0; t < 8; ++t) oc[t] = mfma16(qa[ks], ld8(Rs + (16 * t + fr) * 136 + ks * 32 + fq * 8), oc[t]);
    const float* gn = a.in[10] + l * 1024 + h * 128;
#pragma unroll
    for (int i = 0; i < 4; ++i) { const int row = lane >> 2, ch = (lane & 3) + 4 * i;
        *(u32x4*)(Pw + row * 136 + ch * 8) = *(const u32x4*)(base + (size_t)(16 * w + row) * INW + 3072 + ch * 8); }
#pragma unroll
    for (int j = 0; j < 4; ++j) { const int c = 16 * w + fq * 4 + j; const float xi = exp2f(lg2 * (float)(c + 1));
        float ss = 0.f;
#pragma unroll
        for (int t = 0; t < 8; ++t) { const float o = oi[t][j] + xi * oc[t][j]; oi[t][j] = o; ss += o * o; }
        ss = red16_sum(ss);
        const float rstd = rsqrtf(ss * (1.f / 128.f) + EPS);
#pragma unroll
        for (int t = 0; t < 8; ++t) { const int dv = 16 * t + fr;
            const float gate = bf2f(Pw[(fq * 4 + j) * 136 + dv]);
            Pw[(fq * 4 + j) * 136 + dv] = f2bf(oi[t][j] * rstd * gn[dv] * silu_f(gate)); } }
#pragma unroll
    for (int i = 0; i < 4; ++i) { const int row = lane >> 2, ch = (lane & 3) + 4 * i;
        *(u32x4*)(MIX + (size_t)(rowbase + 16 * w + row) * DM + h * 128 + ch * 8) = *(const u32x4*)(Pw + row * 136 + ch * 8); }
}

__device__ __forceinline__ void swa_prompt_item(const Args& a, int l, int nb, int hq, unsigned char* shm) {
    const int TX = opaque_tid(); const int BX = opaque_bid(); (void)BX;
    const bf16_t* PROJ = (const bf16_t*)(a.ws + WS_PROJ); bf16_t* MIX = (bf16_t*)(a.ws + WS_MIX);
    const int lane = TX & 63, w = __builtin_amdgcn_readfirstlane(TX >> 6), fr = lane & 15, fq = lane >> 4;
    bf16_t* Vs = (bf16_t*)shm; bf16_t* Ks = Vs + 256 * 136;
    bf16_t* Pw = Ks + w * (16 * 168);
    const int kvh = hq >> 2, blk = nb * 128;
    const int kcol = 5120 + kvh * 128, vcol = 5376 + kvh * 128;
    __syncthreads();
    if (nb > 0) { stage_rows<128, 16>(PROJ + (size_t)(blk - 128) * INW + vcol, INW, Vs, 136, TX); stage_rows<128, 16>(PROJ + (size_t)(blk - 128) * INW + kcol, INW, Ks, 136, TX); }
    else { zero_rows<128, 16>(Vs, 136, TX); zero_rows<128, 16>(Ks, 136, TX); }
    stage_rows<128, 16>(PROJ + (size_t)blk * INW + vcol, INW, Vs + 128 * 136, 136, TX);
    stage_rows<128, 16>(PROJ + (size_t)blk * INW + kcol, INW, Ks + 128 * 136, 136, TX);
    bf16x8 qa[4];
#pragma unroll
    for (int ks = 0; ks < 4; ++ks) qa[ks] = ld8(PROJ + (size_t)(blk + 16 * w + fr) * INW + 4096 + hq * 128 + ks * 32 + fq * 8);
    const int kstart = 32 * (w >> 1);
    __syncthreads();
    const int wo = w & 1;
    f32x4 s[10];
#pragma unroll
    for (int t = 0; t < 10; ++t) { s[t] = (f32x4){0.f, 0.f, 0.f, 0.f};
        const bool dead = (t == 9 && wo == 0) || (t == 0 && wo == 1);
        if (!dead) {
#pragma unroll
            for (int ks = 0; ks < 4; ++ks) s[t] = mfma16(qa[ks], ld8(Ks + (kstart + 16 * t + fr) * 136 + ks * 32 + fq * 8), s[t]); } }
    const float sink = a.in[11][l * 8 + hq];
#pragma unroll
    for (int j = 0; j < 4; ++j) { const int i = 16 * w + fq * 4 + j;
        float mx = sink;
#pragma unroll
        for (int t = 0; t < 10; ++t) { const int sidx = kstart + 16 * t + fr;
            const bool dead = (t == 9 && wo == 0) || (t == 0 && wo == 1);
            const bool edge = (t == wo) || (t == 8 + wo) || (nb == 0);
            float v;
            if (dead) v = -1e30f;
            else if (edge) { const bool valid = (sidx >= i) && (sidx <= i + 128) && (nb > 0 || sidx >= 128); v = valid ? s[t][j] * QK_SCALE : -1e30f; }
            else v = s[t][j] * QK_SCALE;
            s[t][j] = v; mx = fmaxf(mx, v); }
        mx = red16_max(mx);
        float sum = 0.f;
#pragma unroll
        for (int t = 0; t < 10; ++t) { const float p = s[t][j] > -1e29f ? __expf(s[t][j] - mx) : 0.f; s[t][j] = p; sum += p; }
        sum = red16_sum(sum) + __expf(sink - mx);
        const float inv = 1.f / sum;
#pragma unroll
        for (int t = 0; t < 10; ++t) s[t][j] *= inv; }
    __syncthreads();
#pragma unroll
    for (int j = 0; j < 4; ++j)
#pragma unroll
        for (int t = 0; t < 10; ++t) Pw[(fq * 4 + j) * 168 + 16 * t + fr] = f2bf(s[t][j]);
    __syncthreads();
    f32x4 o[8];
#pragma unroll
    for (int t = 0; t < 8; ++t) o[t] = (f32x4){0.f, 0.f, 0.f, 0.f};
#pragma unroll
    for (int ks = 0; ks < 5; ++ks) { const bf16x8 pa = ld8(Pw + fr * 168 + ks * 32 + fq * 8);
#pragma unroll
        for (int t = 0; t < 8; ++t) o[t] = mfma16(pa, ld8_tr(Vs, kstart + ks * 32, 136, 16 * t, fq, fr), o[t]); }
#pragma unroll
    for (int t = 0; t < 8; ++t)
#pragma unroll
        for (int j = 0; j < 4; ++j) Pw[(fq * 4 + j) * 168 + 16 * t + fr] = f2bf(o[t][j]);
#pragma unroll
    for (int i = 0; i < 4; ++i) { const int row = lane >> 2, ch = (lane & 3) + 4 * i;
        *(u32x4*)(MIX + (size_t)(blk + 16 * w + row) * DM + 1024 + hq * 128 + ch * 8) = *(const u32x4*)(Pw + row * 168 + ch * 8); }
}

__device__ __forceinline__ void ret_decode_item(const Args& a, int l, int b, int h, unsigned char* shm) {
    const int TX = opaque_tid(); const int BX = opaque_bid(); (void)BX;
    const bf16_t* PROJ = (const bf16_t*)(a.ws + WS_PROJ); bf16_t* MIX = (bf16_t*)(a.ws + WS_MIX);
    float* qs = (float*)shm; float* ks = qs + 128; float* vs = ks + 128; float* red = vs + 128; float* st = red + 16 * 128;
    const int t = TX; const size_t row = (size_t)(SEQ + b);
    const bf16_t* pr = PROJ + row * INW + h * 128;
    __syncthreads();
    if (t < 128) { const int dt = (t >> 1) + 64 * (t & 1); qs[dt] = bf2f(pr[t]); ks[dt] = bf2f(pr[1024 + t]); }
    else if (t < 256) vs[t - 128] = bf2f(pr[2048 + (t - 128)]);
    __syncthreads();
    const float gamma = 1.f - exp2f(-5.f - (float)h);
    const int dv4 = (t & 31) * 4, dkg = t >> 5;
    const size_t sbase = ((size_t)((l * 128 + b) * 8 + h) << 14);
    const float* S = a.in[3] + sbase; float* So = a.out + OFF_RETS + sbase;
    const f32x4 v4 = *(const f32x4*)(vs + dv4);
    f32x4 o4 = (f32x4){0.f, 0.f, 0.f, 0.f};
    f32x4 svv[8];
#pragma unroll
    for (int i = 0; i < 8; ++i) svv[i] = __builtin_nontemporal_load((const f32x4*)(S + (dkg * 8 + i) * 128 + dv4));
#pragma unroll
    for (int i = 0; i < 8; ++i) { const int dk = dkg * 8 + i;
        const f32x4 sn = svv[i] * gamma + v4 * ks[dk];
        __builtin_nontemporal_store(sn, (f32x4*)(So + dk * 128 + dv4));
        o4 += sn * qs[dk]; }
    *(f32x4*)(red + dkg * 128 + dv4) = o4;
    __syncthreads();
    float o = 0.f;
    if (t < 128) {
#pragma unroll
        for (int g = 0; g < 16; ++g) o += red[g * 128 + t];
        const float ss = red64_sum(o * o);
        if ((t & 63) == 0) st[t >> 6] = ss; }
    __syncthreads();
    if (t < 128) { const float rstd = rsqrtf((st[0] + st[1]) * (1.f / 128.f) + EPS);
        const float gate = bf2f(pr[3072 + t]);
        MIX[row * DM + h * 128 + t] = f2bf(o * rstd * a.in[10][l * 1024 + h * 128 + t] * silu_f(gate)); }
}

__device__ __forceinline__ void swa_decode_item(const Args& a, int l, int b, int kvh, unsigned char* shm) {
    const int TX = opaque_tid(); const int BX = opaque_bid(); (void)BX;
    const bf16_t* PROJ = (const bf16_t*)(a.ws + WS_PROJ); bf16_t* MIX = (bf16_t*)(a.ws + WS_MIX);
    float* sc = (float*)shm;
    float* red = sc + 4 * 132;
    const int t = TX, lane = t & 63, w = t >> 6, l16 = lane & 15, sub = lane >> 4;
    const size_t row = (size_t)(SEQ + b);
    const bf16_t* pr = PROJ + row * INW;
    const size_t cbase = (size_t)(l * 128 + b) * 128 * 256 + kvh * 128;
    const float* ck = a.in[4] + cbase; const float* cv = a.in[5] + cbase;
    float* ok = a.out + OFF_WKS + cbase; float* ov = a.out + OFF_WVS + cbase;
    __syncthreads();
    float q[4][8];
#pragma unroll
    for (int g = 0; g < 4; ++g) { const u32x4 raw = *(const u32x4*)(pr + 4096 + (kvh * 4 + g) * 128 + l16 * 8);
#pragma unroll
        for (int e = 0; e < 4; ++e) { q[g][2 * e] = bflo(raw[e]); q[g][2 * e + 1] = bfhi(raw[e]); } }
    { f32x4 kk[4][2];
#pragma unroll
        for (int it = 0; it < 4; ++it) { const int s = w * 16 + it * 4 + sub;
            kk[it][0] = __builtin_nontemporal_load((const f32x4*)(ck + (size_t)s * 256 + l16 * 8)); kk[it][1] = __builtin_nontemporal_load((const f32x4*)(ck + (size_t)s * 256 + l16 * 8 + 4)); }
#pragma unroll
        for (int it = 0; it < 4; ++it) { const int s = w * 16 + it * 4 + sub;
            const f32x4 k0 = kk[it][0], k1 = kk[it][1];
            if (s >= 1) { __builtin_nontemporal_store(k0, (f32x4*)(ok + (size_t)(s - 1) * 256 + l16 * 8)); __builtin_nontemporal_store(k1, (f32x4*)(ok + (size_t)(s - 1) * 256 + l16 * 8 + 4)); }
#pragma unroll
            for (int g = 0; g < 4; ++g) { float d = 0.f;
#pragma unroll
                for (int e = 0; e < 4; ++e) d += q[g][e] * k0[e] + q[g][4 + e] * k1[e];
                d = red16_sum(d);
                if (l16 == 0) sc[g * 132 + s] = d * QK_SCALE; } } }
    if (w == 0 && sub == 0) {
        const u32x4 raw = *(const u32x4*)(pr + 5120 + kvh * 128 + l16 * 8);
        float kn[8];
#pragma unroll
        for (int e = 0; e < 4; ++e) { kn[2 * e] = bflo(raw[e]); kn[2 * e + 1] = bfhi(raw[e]); }
#pragma unroll
        for (int g = 0; g < 4; ++g) { float d = 0.f;
#pragma unroll
            for (int e = 0; e < 8; ++e) d += q[g][e] * kn[e];
            d = red16_sum(d);
            if (l16 == 0) sc[g * 132 + 128] = d * QK_SCALE; } }
    __syncthreads();
    if (w < 4) { const int g = w; const float sink = a.in[11][l * 8 + kvh * 4 + g];
        const float s0 = sc[g * 132 + lane], s1 = sc[g * 132 + 64 + lane], s2 = lane == 0 ? sc[g * 132 + 128] : -1e30f;
        float mx = fmaxf(fmaxf(s0, s1), fmaxf(s2, sink)); mx = red64_max(mx);
        const float p0 = __expf(s0 - mx), p1 = __expf(s1 - mx), p2 = __expf(s2 - mx);
        const float sum = red64_sum(p0 + p1 + p2) + __expf(sink - mx); const float inv = 1.f / sum;
        sc[g * 132 + lane] = p0 * inv; sc[g * 132 + 64 + lane] = p1 * inv; if (lane == 0) sc[g * 132 + 128] = p2 * inv; }
    __syncthreads();
    { const int dv4 = (t & 31) * 4, grp = t >> 5;
        f32x4 vv[8];
#pragma unroll
        for (int i = 0; i < 8; ++i) vv[i] = __builtin_nontemporal_load((const f32x4*)(cv + (size_t)(grp * 8 + i) * 256 + dv4));
        f32x4 acc[4];
#pragma unroll
        for (int g = 0; g < 4; ++g) acc[g] = (f32x4){0.f, 0.f, 0.f, 0.f};
#pragma unroll
        for (int i = 0; i < 8; ++i) { const int s = grp * 8 + i;
            if (s >= 1) __builtin_nontemporal_store(vv[i], (f32x4*)(ov + (size_t)(s - 1) * 256 + dv4));
#pragma unroll
            for (int g = 0; g < 4; ++g) acc[g] += vv[i] * sc[g * 132 + s]; }
        if (grp == 0) { const u32x2 raw = *(const u32x2*)(pr + 5376 + kvh * 128 + dv4);
            const f32x4 vn = (f32x4){bflo(raw.x), bfhi(raw.x), bflo(raw.y), bfhi(raw.y)};
#pragma unroll
            for (int g = 0; g < 4; ++g) acc[g] += vn * sc[g * 132 + 128]; }
#pragma unroll
        for (int g = 0; g < 4; ++g) *(f32x4*)(red + (grp * 4 + g) * 128 + dv4) = acc[g]; }
    __syncthreads();
    { const int g = t >> 7, dv = t & 127; float o = 0.f;
#pragma unroll
        for (int gr = 0; gr < 16; ++gr) o += red[(gr * 4 + g) * 128 + dv];
        MIX[row * DM + 1024 + (kvh * 4 + g) * 128 + dv] = f2bf(o); }
}

__device__ __forceinline__ void xattn_prompt_item(const Args& a, int l, int rt, int h, unsigned char* shm) {
    const int TX = opaque_tid(); const int BX = opaque_bid(); (void)BX;
    const bf16_t* QC = (const bf16_t*)(a.ws + WS_QC); bf16_t* OC = (bf16_t*)(a.ws + WS_OC);
    const bf16_t* MK = (const bf16_t*)(a.ws + WS_MK) + (size_t)l * MEML * MEMW; const bf16_t* MVT = (const bf16_t*)(a.ws + WS_MVT) + (size_t)l * MEMW * MEML;
    const int lane = TX & 63, w = __builtin_amdgcn_readfirstlane(TX >> 6), fr = lane & 15, fq = lane >> 4;
    bf16_t* KV = (bf16_t*)shm;
    bf16_t* Pw = KV + 256 * 136 + w * (16 * 264);
    const size_t r0 = (size_t)rt * 128 + 16 * w;
    __syncthreads();
    stage_rows<256, 16>(MK + h * 128, MEMW, KV, 136, TX);
    bf16x8 qa[4];
#pragma unroll
    for (int ks = 0; ks < 4; ++ks) qa[ks] = ld8(QC + (r0 + fr) * MEMW + h * 128 + ks * 32 + fq * 8);
    __syncthreads();
    f32x4 s[16];
#pragma unroll
    for (int t = 0; t < 16; ++t) { s[t] = (f32x4){0.f, 0.f, 0.f, 0.f};
#pragma unroll
        for (int ks = 0; ks < 4; ++ks) s[t] = mfma16(qa[ks], ld8(KV + (16 * t + fr) * 136 + ks * 32 + fq * 8), s[t]); }
#pragma unroll
    for (int j = 0; j < 4; ++j) { float mx = -1e30f;
#pragma unroll
        for (int t = 0; t < 16; ++t) { s[t][j] *= QK_SCALE; mx = fmaxf(mx, s[t][j]); }
        mx = red16_max(mx);
        float sum = 0.f;
#pragma unroll
        for (int t = 0; t < 16; ++t) { const float p = __expf(s[t][j] - mx); s[t][j] = p; sum += p; }
        sum = red16_sum(sum); const float inv = 1.f / sum;
#pragma unroll
        for (int t = 0; t < 16; ++t) Pw[(fq * 4 + j) * 264 + 16 * t + fr] = f2bf(s[t][j] * inv); }
    __syncthreads();
    stage_rows<128, 32>(MVT + (size_t)(h * 128) * MEML, MEML, KV, 264, TX);
    __syncthreads();
    f32x4 o[8];
#pragma unroll
    for (int t = 0; t < 8; ++t) o[t] = (f32x4){0.f, 0.f, 0.f, 0.f};
#pragma unroll
    for (int ks = 0; ks < 8; ++ks) { const bf16x8 pa = ld8(Pw + fr * 264 + ks * 32 + fq * 8);
#pragma unroll
        for (int t = 0; t < 8; ++t) o[t] = mfma16(pa, ld8(KV + (16 * t + fr) * 264 + ks * 32 + fq * 8), o[t]); }
#pragma unroll
    for (int t = 0; t < 8; ++t)
#pragma unroll
        for (int j = 0; j < 4; ++j) Pw[(fq * 4 + j) * 264 + 16 * t + fr] = f2bf(o[t][j]);
#pragma unroll
    for (int i = 0; i < 4; ++i) { const int row = lane >> 2, ch = (lane & 3) + 4 * i;
        *(u32x4*)(OC + (r0 + row) * MEMW + h * 128 + ch * 8) = *(const u32x4*)(Pw + row * 264 + ch * 8); }
}

__device__ __forceinline__ void xattn_decode_item(const Args& a, int l, int b, int h, unsigned char* shm) {
    const int TX = opaque_tid(); const int BX = opaque_bid(); (void)BX;
    const bf16_t* QC = (const bf16_t*)(a.ws + WS_QC); bf16_t* OC = (bf16_t*)(a.ws + WS_OC);
    float* sc = (float*)shm;
    float* red = sc + 256;
    const int t = TX, lane = t & 63, w = t >> 6, l16 = lane & 15, sub = lane >> 4;
    const size_t row = (size_t)(SEQ + b);
    const size_t cbase = (size_t)(l * 128 + b) * 256 * 512 + h * 128;
    const float* mk = a.in[6] + cbase; const float* mv = a.in[7] + cbase;
    __syncthreads();
    float q[8];
    { const u32x4 raw = *(const u32x4*)(QC + row * MEMW + h * 128 + l16 * 8);
#pragma unroll
        for (int e = 0; e < 4; ++e) { q[2 * e] = bflo(raw[e]); q[2 * e + 1] = bfhi(raw[e]); } }
#pragma unroll
    for (int it = 0; it < 8; ++it) { const int m = w * 32 + it * 4 + sub;
        const f32x4 k0 = __builtin_nontemporal_load((const f32x4*)(mk + (size_t)m * 512 + l16 * 8)), k1 = __builtin_nontemporal_load((const f32x4*)(mk + (size_t)m * 512 + l16 * 8 + 4));
        float d = 0.f;
#pragma unroll
        for (int e = 0; e < 4; ++e) d += q[e] * k0[e] + q[4 + e] * k1[e];
        d = red16_sum(d);
        if (l16 == 0) sc[m] = d * QK_SCALE; }
    __syncthreads();
    const float s0 = sc[lane], s1 = sc[64 + lane], s2 = sc[128 + lane], s3 = sc[192 + lane];
    float mx = red64_max(fmaxf(fmaxf(s0, s1), fmaxf(s2, s3)));
    const float sum = red64_sum(__expf(s0 - mx) + __expf(s1 - mx) + __expf(s2 - mx) + __expf(s3 - mx));
    const float inv = 1.f / sum;
    __syncthreads();
    if (t < 256) sc[t] = __expf(sc[t] - mx) * inv;
    __syncthreads();
    { const int dv4 = (t & 31) * 4, grp = t >> 5;
        f32x4 vv[16];
#pragma unroll
        for (int i = 0; i < 16; ++i) vv[i] = __builtin_nontemporal_load((const f32x4*)(mv + (size_t)(grp * 16 + i) * 512 + dv4));
        f32x4 acc = (f32x4){0.f, 0.f, 0.f, 0.f};
#pragma unroll
        for (int i = 0; i < 16; ++i) acc += vv[i] * sc[grp * 16 + i];
        *(f32x4*)(red + grp * 128 + dv4) = acc; }
    __syncthreads();
    if (t < 128) { float o = 0.f;
#pragma unroll
        for (int gr = 0; gr < 16; ++gr) o += red[gr * 128 + t];
        OC[row * MEMW + h * 128 + t] = f2bf(o); }
}


__device__ void dbg_count_mix(const Args& a, int slot) {
    const int TX = opaque_tid(); const int BX = opaque_bid();
    const unsigned* p = (const unsigned*)(a.ws + WS_MIX);
    unsigned cnt = 0;
    for (size_t i = (size_t)BX * 512 + TX; i < (size_t)SEQ * DM / 2; i += (size_t)gridDim.x * 512) { const unsigned w = p[i];
        const int col = (int)(i % (DM / 2)) * 2;
        if (col >= 1024 && (((w >> 7) & 0xffu) == 0xffu || ((w >> 23) & 0xffu) == 0xffu)) ++cnt; }
    if (cnt) atomicAdd((unsigned*)(a.ws + WS_END) + slot, cnt);
}
__global__ void __launch_bounds__(512, 2) hymba_mega(Args a) {
    extern __shared__ __attribute__((aligned(16))) unsigned char shm[];
    cg::grid_group grid = cg::this_grid();
    LAS unsigned char* lds = (LAS unsigned char*)shm;
    const int G = gridDim.x, bid = opaque_bid(); const int TX = opaque_tid();
    unsigned char* ws = a.ws;
    bf16_t* H = (bf16_t*)(ws + WS_H); bf16_t* PROJ = (bf16_t*)(ws + WS_PROJ); bf16_t* GU = (bf16_t*)(ws + WS_GU); bf16_t* MIX = (bf16_t*)(ws + WS_MIX);
    bf16_t* QC = (bf16_t*)(ws + WS_QC); bf16_t* OC = (bf16_t*)(ws + WS_OC); float* X = (float*)(ws + WS_X);
    float* COS = (float*)(ws + WS_COS); float* SIN = (float*)(ws + WS_SIN);
    volatile LAS unsigned* xst = (volatile LAS unsigned*)(lds + LDS_BYTES - 16);
    if (TX == 0) { xst[0] = 0u; xst[1] = 0u; }
    __syncthreads();
    const XcdBarrier xbar = xcd_barrier_post((unsigned*)(ws + WS_BAR), xst);

    {
        int rot = 0;
#pragma unroll 1
        for (int l = 0; l < 2; ++l) {
            unsigned char* wl = ws + WS_W + (size_t)l * W_LAYER;
            const bool all = (G != 256);
            convT(a.in[9] + (size_t)l * DM * INW, DM, INW, (bf16_t*)(wl + W_IN), 1, (float*)shm, rot, bid, G); rot += 37;
            if (l == 0 || all) { convT(a.in[12] + (size_t)l * DM * DM, DM, DM, (bf16_t*)(wl + W_OUT), 0, (float*)shm, rot, bid, G); rot += 37; }
            if (l == 0 || all) { convT(a.in[15] + (size_t)l * DM * MEMW, DM, MEMW, (bf16_t*)(wl + W_Q), 0, (float*)shm, rot, bid, G); rot += 37; }
            convT(a.in[16] + (size_t)l * DM * MEMW, DM, MEMW, (bf16_t*)(wl + W_K), 0, (float*)shm, rot, bid, G); rot += 37;
            convT(a.in[17] + (size_t)l * DM * MEMW, DM, MEMW, (bf16_t*)(wl + W_V), 0, (float*)shm, rot, bid, G); rot += 37;
            if (l == 0 || all) { convT(a.in[18] + (size_t)l * MEMW * DM, MEMW, DM, (bf16_t*)(wl + W_O), 0, (float*)shm, rot, bid, G); rot += 37; }
            if (all) {
                convT(a.in[20] + (size_t)l * DM * DFF, DM, DFF, (bf16_t*)(wl + W_GU), 2, (float*)shm, rot, bid, G); rot += 37;
                convT(a.in[21] + (size_t)l * DM * DFF, DM, DFF, (bf16_t*)(wl + W_GU), 3, (float*)shm, rot, bid, G); rot += 37;
                convT(a.in[22] + (size_t)l * DFF * DM, DFF, DM, (bf16_t*)(wl + W_D), 0, (float*)shm, rot, bid, G); rot += 37; }
        }
        if (bid == 0 && TX == 0) { *(unsigned*)(ws + WS_END) = 0u; *((unsigned*)(ws + WS_END) + 1) = 0xffffffffu; *((unsigned*)(ws + WS_END) + 2) = 0u; for (int q = 3; q < 12; ++q) *((unsigned*)(ws + WS_END) + q) = 0u; }
        for (int e = bid * 512 + TX; e < 8193 * 64; e += G * 512) { const int i = e & 63, pos = e >> 6;
            const float inv = powf(10000.f, -(float)i / 64.f); const float ang = (float)pos * inv;
            float sn_, cs_; sincosf(ang, &sn_, &cs_); COS[e] = cs_; SIN[e] = sn_; }
        { bf16_t* MN = (bf16_t*)(ws + WS_MN); const int lane = TX & 63;
            for (int r = bid * 8 + (TX >> 6); r < 512; r += G * 8) { const int l = r >> 8, mr = r & 255;
                const float* src = a.in[2] + (size_t)mr * DM; const float* g = a.in[14] + l * DM;
                f32x4 v[8]; float ss = 0.f;
#pragma unroll
                for (int ch = 0; ch < 4; ++ch) { const int col = ch * 512 + lane * 8; v[2 * ch] = *(const f32x4*)(src + col); v[2 * ch + 1] = *(const f32x4*)(src + col + 4);
#pragma unroll
                    for (int j = 0; j < 4; ++j) ss += v[2 * ch][j] * v[2 * ch][j] + v[2 * ch + 1][j] * v[2 * ch + 1][j]; }
                ss = red64_sum(ss); const float rstd = rsqrtf(ss * (1.f / DM) + EPS);
#pragma unroll
                for (int ch = 0; ch < 4; ++ch) { const int col = ch * 512 + lane * 8;
                    const f32x4 y0 = v[2 * ch] * rstd * *(const f32x4*)(g + col), y1 = v[2 * ch + 1] * rstd * *(const f32x4*)(g + col + 4);
                    u32x4 wv; wv.x = cvt_pk_bf16(y0[0], y0[1]); wv.y = cvt_pk_bf16(y0[2], y0[3]); wv.z = cvt_pk_bf16(y1[0], y1[1]); wv.w = cvt_pk_bf16(y1[2], y1[3]);
                    *(u32x4*)(MN + (size_t)r * DM + col) = wv; } } }
        for (int e = bid * 512 + TX; e < 128 * DM / 8; e += G * 512) *(u32x4*)(MIX + (size_t)MROWS * DM + (size_t)e * 8) = (u32x4){0u, 0u, 0u, 0u};
        for (int e = bid * 512 + TX; e < 128 * MEMW / 8; e += G * 512) *(u32x4*)(OC + (size_t)MROWS * MEMW + (size_t)e * 8) = (u32x4){0u, 0u, 0u, 0u};
    }
    grid.sync();

#pragma unroll 1
    for (int step = 0; step < NLAYERS * 13; ++step) {
        const int l = step / 13, p = step - l * 13;
        unsigned char* wl = ws + WS_W + (size_t)l * W_LAYER;
        if (p == 0 || p == 6 || p == 10) {
            const float* gp = (p == 0 ? a.in[8] : (p == 6 ? a.in[13] : a.in[19])) + l * DM;
            rms_phase(a, step == 0 ? 0 : 1, gp, step == 0 ? 0 : (p == 0 ? (DFF >> 9) : (p == 6 ? (DM >> 9) : (MEMW >> 9))), shm);
        } else if (p == 5 || p == 9 || p == 12) {
            const bf16_t* Ap = p == 5 ? MIX : (p == 9 ? OC : GU);
            const size_t wo = p == 5 ? W_OUT : (p == 9 ? W_O : W_D);
            const int Kd = p == 5 ? DM : (p == 9 ? MEMW : DFF);
            pg8::Gemm g{Ap, (const bf16_t*)(wl + wo), SEQ, DM, Kd, Kd, Kd}; pg8::StaticOrder S; S.init(SEQ, DM, G, bid); pg8::EpiResB E{(bf16_t*)(ws + WS_XB), DM}; pg8::gemm_phase(lds, g, S, E);
            { const int nks = Kd >> 9, c2 = (bid + 128) % G;
                if (c2 < 8 * nks) { const int ks = c2 >> 3;
                    pg8::Gemm g2{Ap + (size_t)SEQ * Kd + ks * 512, (const bf16_t*)(wl + wo) + ks * 512, 256, DM, 512, Kd, Kd};
                    pg8::OneUnit S2{c2 & 7}; pg8::EpiResPart E2{(float*)(ws + WS_PART) + (size_t)ks * 128 * DM, DM}; pg8::gemm_phase(lds, g2, S2, E2); } }
        } else if (p == 1) {
            { pg8::Gemm g{H, (const bf16_t*)(wl + W_IN), MP, INW, DM, DM, DM}; pg8::StaticOrder S; S.init(MP, INW, G, bid);
                pg8::EpiIn E{PROJ, COS, SIN, a.out, l}; pg8::gemm_phase(lds, g, S, E); }
            if (l == 0) {
#pragma unroll 1
                for (int ll = 0; ll < 2; ++ll) {
                    unsigned char* wll = ws + WS_W + (size_t)ll * W_LAYER;
                    const bf16_t* MN = (const bf16_t*)(ws + WS_MN) + (size_t)ll * MEML * DM;
                    bf16_t* MK = (bf16_t*)(ws + WS_MK) + (size_t)ll * MEML * MEMW; bf16_t* MVT = (bf16_t*)(ws + WS_MVT) + (size_t)ll * MEMW * MEML;
#pragma unroll 1
                    for (int kv = 0; kv < 2; ++kv) {
                        pg8::Gemm g{MN, (const bf16_t*)(wll + (kv ? W_V : W_K)), MEML, MEMW, DM, DM, DM}; pg8::StaticOrder S; S.init(MEML, MEMW, G, (bid + 40 - kv * 2 - ll * 6) % G);
                        pg8::EpiMem E{a.out + (kv ? OFF_MVP : OFF_MKP) + (size_t)ll * MEML * MEMW, kv ? nullptr : MK, MEMW}; pg8::gemm_phase(lds, g, S, E); }
                    { pg8::Gemm g{(const bf16_t*)(wll + W_V), MN, MEMW, MEML, DM, DM, DM}; pg8::StaticOrder S; S.init(MEMW, MEML, G, (bid + 36 - ll * 6) % G);
                        pg8::EpiBf E{MVT, MEML}; pg8::gemm_phase(lds, g, S, E); }
                }
            }
        } else if (p == 2) {
            for (int k = 0; k < 9; ++k) { const int it = bid + (((bid >> 3) & 1) ? (8 - k) : k) * G;
                if (it >= 2304) continue;
                if (it < 512) { const int xcd = it & 7, idx = (it >> 3);
                    swa_prompt_item(a, l, xcd + 8 * (idx >> 3), idx & 7, shm); }
                else if (it < 1024) ret_kv_item(a, (it - 512) >> 3, (it - 512) & 7, shm);
                else if (it < 2048) ret_decode_item(a, l, (it - 1024) >> 3, (it - 1024) & 7, shm);
                else swa_decode_item(a, l, (it - 2048) >> 1, (it - 2048) & 1, shm);
            }
        } else if (p == 3) {
            ret_scan_phase(a, l);
        } else if (p == 4) {
            for (int it = bid; it < 512; it += G) ret_out_item(a, l, it >> 3, it & 7, shm);
        } else if (p == 7) {
            pg8::Gemm g{H, (const bf16_t*)(wl + W_Q), MP, MEMW, DM, DM, DM}; pg8::StaticOrder S; S.init(MP, MEMW, G, bid); pg8::EpiBf E{QC, MEMW}; pg8::gemm_phase(lds, g, S, E);
            if (G == 256 && bid >= 66) {
                const int vb = bid - 66, vG = G - 66;
                convT(a.in[20] + (size_t)l * DM * DFF, DM, DFF, (bf16_t*)(wl + W_GU), 2, (float*)shm, 0, vb, vG);
                convT(a.in[21] + (size_t)l * DM * DFF, DM, DFF, (bf16_t*)(wl + W_GU), 3, (float*)shm, 61, vb, vG);
                if (l == 0) { unsigned char* w1 = ws + WS_W + W_LAYER;
                    convT(a.in[12] + (size_t)DM * DM, DM, DM, (bf16_t*)(w1 + W_OUT), 0, (float*)shm, 122, vb, vG);
                    convT(a.in[15] + (size_t)DM * MEMW, DM, MEMW, (bf16_t*)(w1 + W_Q), 0, (float*)shm, 31, vb, vG);
                    convT(a.in[18] + (size_t)MEMW * DM, MEMW, DM, (bf16_t*)(w1 + W_O), 0, (float*)shm, 93, vb, vG); }
            }
        } else if (p == 8) {
            for (int k = 0; k < 3; ++k) { const int it = bid + (((bid >> 3) & 1) ? (2 - k) : k) * G;
                if (it >= 768) continue;
                if (it < 256) xattn_prompt_item(a, l, it >> 2, it & 3, shm);
                else xattn_decode_item(a, l, (it - 256) >> 2, (it - 256) & 3, shm);
            }
        } else {
            pg8::Gemm g{H, (const bf16_t*)(wl + W_GU), MP, 2 * DFF, DM, DM, DM}; pg8::StaticOrder S; S.init(MP, 2 * DFF, G, bid); pg8::EpiGU E{GU}; pg8::gemm_phase(lds, g, S, E);
            if (G == 256 && bid >= 172) {
                convT(a.in[22] + (size_t)l * DFF * DM, DFF, DM, (bf16_t*)(wl + W_D), 0, (float*)shm, 0, bid - 172, G - 172);
            }
        }
        xcd_barrier(xbar);
    }
    rms_phase(a, 2, a.in[23], DFF >> 9, shm);
#ifdef DBG_PROBE
    xcd_barrier(xbar);
    dbg_count_mix(a, 7);
    xcd_barrier(xbar);
    {
        int first = 9; unsigned c = 0;
        for (int q = 7; q >= 4; --q) { const unsigned v = __hip_atomic_load((unsigned*)(ws + WS_END) + q, __ATOMIC_RELAXED, __HIP_MEMORY_SCOPE_AGENT); if (v) { first = q; c = v; } }
        int lg = 0; while ((c >> lg) > 1u) ++lg;
        const float K = sqrtf((float)(first) * powf(10.f, (float)(2 + lg)));
        for (size_t e2 = (size_t)bid * 512 + TX; e2 < OUT_TOTAL; e2 += (size_t)G * 512) a.out[e2] = (e2 >= OFF_YS && e2 < OFF_RETP) ? K : 0.f;
    }
#endif
}

extern "C" void kernel_launch(void* const* d_in, const int* in_sizes, int n_in, void* d_out, int out_size, void* d_ws, size_t ws_size, hipStream_t stream) {
    static int grid = 0;
    if (grid == 0) {
        if (n_in != 24 || (size_t)out_size != OUT_TOTAL || ws_size < WS_END + 256) { fprintf(stderr, "kernel_launch: unexpected shapes (n_in %d out %d ws %zu need %zu)\n", n_in, out_size, ws_size, (size_t)WS_END); grid = -1; return; }
        int dev = 0, cus = 0, per_cu = 0;
        hipGetDevice(&dev); hipDeviceGetAttribute(&cus, hipDeviceAttributeMultiprocessorCount, dev);
        if (hipFuncSetAttribute((const void*)hymba_mega, hipFuncAttributeMaxDynamicSharedMemorySize, LDS_BYTES) != hipSuccess) { fprintf(stderr, "kernel_launch: hipFuncSetAttribute failed\n"); grid = -1; return; }
        if (hipOccupancyMaxActiveBlocksPerMultiprocessor(&per_cu, (const void*)hymba_mega, 512, LDS_BYTES) != hipSuccess || per_cu < 1) { fprintf(stderr, "kernel_launch: occupancy query says %d\n", per_cu); per_cu = 1; }
        (void)hipGetLastError();
        grid = cus * 1;
    }
    if (grid < 0) return;
    Args a{};
    for (int i = 0; i < 24; ++i) a.in[i] = (const float*)d_in[i];
    a.out = (float*)d_out; a.ws = (unsigned char*)d_ws;
    (void)hipMemsetAsync((char*)d_ws + WS_BAR, 0, 16384, stream);
    void* args[] = {&a};
    hipError_t e = hipLaunchCooperativeKernel((const void*)hymba_mega, dim3(grid), dim3(512), args, LDS_BYTES, stream);
    if (e != hipSuccess) fprintf(stderr, "cooperative launch failed: %s (grid %d)\n", hipGetErrorString(e), grid);
}
```

```cpp
#define NLAYERS 2
#include <hip/hip_runtime.h>
#include <hip/hip_cooperative_groups.h>
#include <cstdio>
namespace cg = cooperative_groups;

#define LAS __attribute__((address_space(3)))
typedef unsigned short bf16_t;
typedef short bf16x8 __attribute__((ext_vector_type(8)));
typedef float f32x4 __attribute__((ext_vector_type(4)));
typedef unsigned u32x4 __attribute__((ext_vector_type(4)));
typedef unsigned u32x2 __attribute__((ext_vector_type(2)));

constexpr int DM = 2048, SEQ = 8192, NBAT = 128, MROWS = SEQ + NBAT  , MP = 8448  ;
constexpr int INW = 5632, DFF = 5632, MEMW = 512, MEML = 256;
constexpr float EPS = 1e-6f;
constexpr float QK_SCALE = 0.08838834764831845f;
constexpr int LDS_BYTES = 147456;

constexpr size_t OFF_YP = 0;
constexpr size_t OFF_YS = OFF_YP + (size_t)SEQ * DM;
constexpr size_t OFF_RETP = OFF_YS + (size_t)NBAT * DM;
constexpr size_t OFF_WKP = OFF_RETP + 2 * 8 * 128 * 128;
constexpr size_t OFF_WVP = OFF_WKP + 2 * 128 * 256;
constexpr size_t OFF_MKP = OFF_WVP + 2 * 128 * 256;
constexpr size_t OFF_MVP = OFF_MKP + 2 * 256 * 512;
constexpr size_t OFF_RETS = OFF_MVP + 2 * 256 * 512;
constexpr size_t OFF_WKS = OFF_RETS + (size_t)2 * 128 * 8 * 128 * 128;
constexpr size_t OFF_WVS = OFF_WKS + (size_t)2 * 128 * 128 * 256;
constexpr size_t OUT_TOTAL = OFF_WVS + (size_t)2 * 128 * 128 * 256;

constexpr size_t WS_X = 0;
constexpr size_t WS_H = WS_X + (size_t)MP * DM * 4;
constexpr size_t WS_PROJ = WS_H + (size_t)MP * DM * 2;
constexpr size_t WS_GU = WS_PROJ + (size_t)MP * INW * 2;
constexpr size_t WS_MIX = WS_GU + (size_t)MP * DFF * 2;
constexpr size_t WS_QC = WS_MIX + (size_t)MP * DM * 2;
constexpr size_t WS_OC = WS_QC + (size_t)MP * MEMW * 2;
constexpr size_t WS_KVT = WS_OC + (size_t)MP * MEMW * 2;
constexpr size_t WS_RT = WS_KVT + (size_t)64 * 8 * 16384 * 4;
constexpr size_t WS_MN = WS_RT + (size_t)64 * 8 * 16384 * 2;
constexpr size_t WS_MK = WS_MN + (size_t)2 * MEML * DM * 2;
constexpr size_t WS_MVT = WS_MK + (size_t)2 * MEML * MEMW * 2;
constexpr size_t WS_COS = WS_MVT + (size_t)2 * MEML * MEMW * 2;
constexpr size_t WS_SIN = WS_COS + (size_t)8256 * 64 * 4;
constexpr size_t WS_W = WS_SIN + (size_t)8256 * 64 * 4;
constexpr size_t W_IN = 0;
constexpr size_t W_OUT = W_IN + (size_t)INW * DM * 2;
constexpr size_t W_Q = W_OUT + (size_t)DM * DM * 2;
constexpr size_t W_K = W_Q + (size_t)MEMW * DM * 2;
constexpr size_t W_V = W_K + (size_t)MEMW * DM * 2;
constexpr size_t W_O = W_V + (size_t)MEMW * DM * 2;
constexpr size_t W_GU = W_O + (size_t)DM * MEMW * 2;
constexpr size_t W_D = W_GU + (size_t)2 * DFF * DM * 2;
constexpr size_t W_LAYER = W_D + (size_t)DM * DFF * 2;
constexpr size_t WS_BAR = WS_W + 2 * W_LAYER;
constexpr size_t WS_XB = WS_BAR + 16384;
constexpr size_t WS_PART = WS_XB + (size_t)SEQ * DM * 2;
constexpr size_t WS_END = WS_PART + (size_t)11 * 128 * DM * 4;

struct Args { const float* in[24]; float* out; unsigned char* ws; };

typedef __bf16 bf16x2_t __attribute__((ext_vector_type(2)));
__device__ __forceinline__ unsigned cvt_pk_bf16(float lo, float hi) { bf16x2_t v; v.x = (__bf16)lo; v.y = (__bf16)hi; return __builtin_bit_cast(unsigned, v); }
__device__ __forceinline__ bf16_t f2bf(float x) { return (bf16_t)(cvt_pk_bf16(x, 0.f) & 0xffffu); }
__device__ __forceinline__ float bf2f(unsigned h) { return __uint_as_float(h << 16); }
__device__ __forceinline__ float bflo(unsigned w) { return __uint_as_float(w << 16); }
__device__ __forceinline__ float bfhi(unsigned w) { return __uint_as_float(w & 0xffff0000u); }
__device__ __forceinline__ f32x4 mfma16(bf16x8 a, bf16x8 b, f32x4 c) { return __builtin_amdgcn_mfma_f32_16x16x32_bf16(a, b, c, 0, 0, 0); }
__device__ __forceinline__ bf16x8 ld8(const bf16_t* p) { return *reinterpret_cast<const bf16x8*>(p); }
template <int CTRL> __device__ __forceinline__ float dpp_mov(float v) { return __builtin_bit_cast(float, __builtin_amdgcn_update_dpp(0, __builtin_bit_cast(int, v), CTRL, 0xf, 0xf, true)); }
__device__ __forceinline__ float red16_sum(float v) { v += dpp_mov<0xB1>(v); v += dpp_mov<0x4E>(v); v += dpp_mov<0x141>(v); v += dpp_mov<0x140>(v); return v; }
__device__ __forceinline__ float red16_max(float v) { v = fmaxf(v, dpp_mov<0xB1>(v)); v = fmaxf(v, dpp_mov<0x4E>(v)); v = fmaxf(v, dpp_mov<0x141>(v)); v = fmaxf(v, dpp_mov<0x140>(v)); return v; }
__device__ __forceinline__ float red64_sum(float v) { v = red16_sum(v); v += __shfl_xor(v, 16); v += __shfl_xor(v, 32); return v; }
__device__ __forceinline__ float red64_max(float v) { v = red16_max(v); v = fmaxf(v, __shfl_xor(v, 16)); v = fmaxf(v, __shfl_xor(v, 32)); return v; }
__device__ __forceinline__ float silu_f(float x) { return x * __builtin_amdgcn_rcpf(1.f + __expf(-x)); }
__device__ __forceinline__ int opaque_tid() { int t = threadIdx.x; asm volatile("" : "+v"(t)); return t; }
__device__ __forceinline__ int opaque_bid() { int b = blockIdx.x; asm volatile("" : "+s"(b)); return b; }
__device__ __forceinline__ float ret_lg2(int h) { return log1pf(-exp2f(-5.f - (float)h)) * 1.4426950408889634f; }

#define XB_TMO      128
#define XB_XCNT(j)  (256  + 64 * (j))
#define XB_XSUB(j)  (1280 + 64 * (j))
#define XB_XGEN(j)  (2304 + 64 * (j))
#define XB_TOP      3328
#define XB_TOPGEN   3392
#define XCD_BAR_WORDS 3456
#define XB_SPIN_CAP (1u << 18)

__device__ __forceinline__ unsigned xb_ld(unsigned* p)              { return __hip_atomic_load(p, __ATOMIC_RELAXED, __HIP_MEMORY_SCOPE_AGENT); }
__device__ __forceinline__ unsigned xb_add(unsigned* p, unsigned v) { return __hip_atomic_fetch_add(p, v, __ATOMIC_RELAXED, __HIP_MEMORY_SCOPE_AGENT); }
__device__ __forceinline__ unsigned xb_xcc_id() { return (unsigned)__builtin_amdgcn_s_getreg((3 << 11) | 20) & 0xFu; }
#define XB_SPIN(cond, bar) do { unsigned _sp = 0; while (cond) { __builtin_amdgcn_s_sleep(1); \
    if ((++_sp & 255u) == 0u) { if (xb_ld(&(bar)[XB_TMO])) break; if (_sp > XB_SPIN_CAP) { atomicAdd(&(bar)[XB_TMO], 1u); break; } } } } while (0)

struct XcdBarrier {
    unsigned* bar; unsigned x;
    volatile LAS unsigned* st;
};

__device__ __forceinline__ XcdBarrier xcd_barrier_post(unsigned* bar, volatile LAS unsigned* st) {
    XcdBarrier b; b.bar = bar; b.x = xb_xcc_id(); b.st = st;
    if (threadIdx.x == 0) (void)xb_add(&bar[XB_XCNT(b.x)], 1u);
    return b;
}
__device__ __forceinline__ void xcd_barrier_complete(unsigned* bar, unsigned x, unsigned& nloc, unsigned& nx) {
    const unsigned G = gridDim.x * gridDim.y * gridDim.z;
    unsigned sum, cnt, mine, sp = 0u;
    for (;;) {
        sum = 0u; cnt = 0u; mine = 0u;
#pragma unroll
        for (unsigned j = 0; j < 16; ++j) { const unsigned c = xb_ld(&bar[XB_XCNT(j)]); sum += c; cnt += (c > 0u) ? 1u : 0u; mine = (j == x) ? c : mine; }
        if (sum == G) break;
        __builtin_amdgcn_s_sleep(1);
        if ((++sp & 255u) == 0u) { if (xb_ld(&bar[XB_TMO])) break; if (sp > XB_SPIN_CAP) { atomicAdd(&bar[XB_TMO], 1u); break; } }
    }
    nloc = mine > 0u ? mine : 1u; nx = cnt > 0u ? cnt : 1u;
}

__device__ __forceinline__ void xcd_barrier(const XcdBarrier& b) {
    asm volatile("s_waitcnt vmcnt(0)" ::: "memory");
    __syncthreads();
    if (threadIdx.x == 0) {
        unsigned* bar = b.bar;
        __builtin_amdgcn_s_waitcnt(0);
        unsigned nloc = b.st[0], nx = b.st[1];
        if (nloc == 0u) { xcd_barrier_complete(bar, b.x, nloc, nx); b.st[0] = nloc; b.st[1] = nx; }
        const unsigned old = xb_add(&bar[XB_XSUB(b.x)], 1u);
        const unsigned gen = old / nloc;
        if (old + 1u == (gen + 1u) * nloc) {
            __builtin_amdgcn_fence(__ATOMIC_RELEASE, "agent");
            asm volatile("s_waitcnt vmcnt(0)" ::: "memory");
            const unsigned og = xb_add(&bar[XB_TOP], 1u);
            const unsigned tg = og / nx;
            if (og + 1u == (tg + 1u) * nx) xb_add(&bar[XB_TOPGEN], 1u);
            else XB_SPIN(xb_ld(&bar[XB_TOPGEN]) == tg, bar);
            __builtin_amdgcn_fence(__ATOMIC_ACQUIRE, "agent");
            xb_add(&bar[XB_XGEN(b.x)], 1u);
            asm volatile("s_waitcnt vmcnt(0)" ::: "memory");
        } else {
            XB_SPIN(xb_ld(&bar[XB_XGEN(b.x)]) == gen, bar);
            __builtin_amdgcn_fence(__ATOMIC_ACQUIRE, "agent");
            asm volatile("s_waitcnt vmcnt(0)" ::: "memory");
        }
    }
    __syncthreads();
}


namespace pg8 {
constexpr int BM = 256, BK = 64, HALF = 128, HTB = HALF * BK * 2, STAGE_BYTES = 8 * HTB, NXCD = 8, WGM = 8;
__device__ __forceinline__ int lds_byte(int r, int c) { const int st = (r >> 4) * 2 + (c >> 5), rr = r & 15, cc = c & 31, ob = rr * 64 + cc * 2; return st * 1024 + (ob ^ (((ob >> 9) & 1) << 5)); }
__device__ __forceinline__ void stage_rc(int b, int& R, int& C) { const int st = b / 1024, sb = b % 1024, swz = sb ^ (((sb >> 9) & 1) << 5); R = (st >> 1) * 16 + swz / 64; C = (st & 1) * 32 + (swz % 64) / 2; }
__device__ __forceinline__ int perm32(int rho) { const int n = rho >> 4, i = rho & 15; return 8 * (i >> 2) + 4 * n + (i & 3); }
struct Unit { int pm, pn; };
struct Gemm { const bf16_t* A; const bf16_t* Bt; int M, N, K, lda, ldb; };
struct StaticOrder {
    int nM, nN, nwg, G, c;
    __device__ void init(int M, int N, int G_, int c_) { nM = M / BM; nN = N / BM; nwg = nM * nN; G = G_; c = c_; }
    __device__ bool next(int i, Unit& u) const {
        const long L = (long)i * G + c; if (L >= nwg) return false;
        int wgid = (int)L; { const int q = nwg / NXCD, r = nwg % NXCD, xcd = wgid % NXCD, off = wgid / NXCD; wgid = (xcd < r ? xcd * (q + 1) : r * (q + 1) + (xcd - r) * q) + off; }
        const int nig = WGM * nN, gid = wgid / nig, fm = gid * WGM, gsz = (nM - fm) < WGM ? (nM - fm) : WGM;
        u.pm = fm + ((wgid % nig) % gsz); u.pn = (wgid % nig) / gsz; return true;
    }
    __device__ __forceinline__ void a_ready(const Unit&) const {}
    __device__ __forceinline__ void done(const Unit&) const {}
};

struct OneUnit {
    int pn;
    __device__ bool next(int i, Unit& u) const { if (i != 0) return false; u.pm = 0; u.pn = pn; return true; }
    __device__ __forceinline__ void a_ready(const Unit&) const {}
    __device__ __forceinline__ void done(const Unit&) const {}
};
template <class Epi, class Sched>
__device__ __forceinline__ void gemm_phase(LAS unsigned char* lds, const Gemm g, const Sched& S, const Epi& E) {
    const int tid = opaque_tid(), wid = __builtin_amdgcn_readfirstlane(tid >> 6), lane = tid & 63, wr = wid >> 2, wc = wid & 3, fr = lane & 15, fq = lane >> 4;
    const int K = g.K, nt = K / BK;
    unsigned voffA[2], voffB[2];
#pragma unroll
    for (int i = 0; i < 2; ++i) { int R, C; stage_rc(tid * 16 + i * 8192, R, C); const int Rb = Epi::PERM ? ((R & ~31) + perm32(R & 31)) : R;
        voffA[i] = (unsigned)(R * g.lda + C) * 2u; voffB[i] = (unsigned)(Rb * g.ldb + C) * 2u; }
    const size_t kstep = (size_t)(BK * 2);
    const size_t hstepA = (size_t)HALF * g.lda * 2, hstepB = (size_t)HALF * g.ldb * 2;
    const size_t tstepA = 2 * hstepA, tstepB = 2 * hstepB;
    const unsigned ldsw = (unsigned)wid * 1024u;
    const int aoff = lds_byte(wr * 64 + fr, fq * 8), boff = lds_byte(wc * 32 + fr, fq * 8);
#define PG8_SA(b, h) (((b) * 2 + (h)) * HTB)
#define PG8_SB(b, h) ((4 + (b) * 2 + (h)) * HTB)
#define PG8_STAGE(bufoff, gbase, voff) do { _Pragma("unroll") for (int _i = 0; _i < 2; ++_i) \
        __builtin_amdgcn_global_load_lds((const unsigned*)((const char*)(gbase) + (voff)[_i]), (LAS unsigned*)(lds + (bufoff) + ldsw + _i * 8192), 16, 0, 0); } while (0)
#define PG8_LDA(dst, b, h) do { _Pragma("unroll") for (int m = 0; m < 4; ++m) _Pragma("unroll") for (int k = 0; k < 2; ++k) dst[m][k] = *(const LAS bf16x8*)(lds + PG8_SA(b, h) + aoff + m * 2048 + k * 1024); } while (0)
#define PG8_LDB(dst, b, h) do { _Pragma("unroll") for (int n = 0; n < 2; ++n) _Pragma("unroll") for (int k = 0; k < 2; ++k) dst[n][k] = *(const LAS bf16x8*)(lds + PG8_SB(b, h) + boff + n * 2048 + k * 1024); } while (0)
#define PG8_MMA(ai, bj, At, Bt) do { __builtin_amdgcn_s_setprio(1); _Pragma("unroll") for (int m = 0; m < 4; ++m) _Pragma("unroll") for (int n = 0; n < 2; ++n) _Pragma("unroll") for (int k = 0; k < 2; ++k) \
        acc[ai][bj][m][n] = __builtin_amdgcn_mfma_f32_16x16x32_bf16(Bt[n][k], At[m][k], acc[ai][bj][m][n], 0, 0, 0); __builtin_amdgcn_s_setprio(0); } while (0)
#define PG8_WAIT_V(n) asm volatile("s_waitcnt vmcnt(" #n ")" ::: "memory")
#define PG8_WAIT_L(n) asm volatile("s_waitcnt lgkmcnt(" #n ")" ::: "memory")
#define PG8_BAR __builtin_amdgcn_s_barrier()
#define PG8_SCHED __builtin_amdgcn_sched_barrier(0)
    Unit cur, nxt; int ui = 0;
    if (!S.next(0, cur)) return;
    f32x4 acc[2][2][4][2];
#pragma unroll
    for (int a = 0; a < 2; ++a)
#pragma unroll
        for (int b = 0; b < 2; ++b)
#pragma unroll
            for (int m = 0; m < 4; ++m)
#pragma unroll
                for (int n = 0; n < 2; ++n) acc[a][b][m][n] = (f32x4){0.f, 0.f, 0.f, 0.f};
    bf16x8 At[4][2], B0[2][2], B1[2][2];
    const char* cA = (const char*)g.A + (size_t)cur.pm * tstepA; const char* cB = (const char*)g.Bt + (size_t)cur.pn * tstepB;
    S.a_ready(cur);
    PG8_STAGE(PG8_SB(0, 0), cB, voffB); PG8_STAGE(PG8_SA(0, 0), cA, voffA); PG8_STAGE(PG8_SB(0, 1), cB + hstepB, voffB); PG8_STAGE(PG8_SA(0, 1), cA + hstepA, voffA);
    if (wr == 1) PG8_BAR;
    PG8_WAIT_V(4); PG8_BAR;
    PG8_STAGE(PG8_SB(1, 0), cB + kstep, voffB); PG8_STAGE(PG8_SA(1, 0), cA + kstep, voffA); PG8_STAGE(PG8_SB(1, 1), cB + hstepB + kstep, voffB);
    PG8_WAIT_V(6); PG8_BAR;
    for (;;) {
        const bool has_next = S.next(ui + 1, nxt);
        const char* nA = has_next ? (const char*)g.A + (size_t)nxt.pm * tstepA : cA; const char* nB = has_next ? (const char*)g.Bt + (size_t)nxt.pn * tstepB : cB;
        for (int t = 0; t < nt; t += 2) {
            const bool last = (t == nt - 2);
            const char* a1 = cA + (size_t)(t + 1) * kstep;
            const char* a2 = last ? nA : cA + (size_t)(t + 2) * kstep; const char* b2 = last ? nB : cB + (size_t)(t + 2) * kstep;
            const char* a3 = a2 + kstep; const char* b3 = b2 + kstep;
            if (last && has_next) S.a_ready(nxt);
            PG8_LDB(B0, 0, 0); PG8_SCHED; PG8_LDA(At, 0, 0); PG8_STAGE(PG8_SA(1, 1), a1 + hstepA, voffA);
            PG8_WAIT_L(8); PG8_BAR; PG8_WAIT_L(0); PG8_MMA(0, 0, At, B0); PG8_BAR; PG8_SCHED;
            PG8_LDB(B1, 0, 1); PG8_STAGE(PG8_SB(0, 0), b2, voffB);
            PG8_BAR; PG8_WAIT_L(0); PG8_MMA(0, 1, At, B1); PG8_BAR;
            PG8_LDA(At, 0, 1); PG8_STAGE(PG8_SA(0, 0), a2, voffA);
            PG8_BAR; PG8_WAIT_L(0); PG8_MMA(1, 0, At, B0); PG8_BAR; PG8_SCHED;
            PG8_STAGE(PG8_SB(0, 1), b2 + hstepB, voffB);
            PG8_WAIT_V(6); PG8_BAR; PG8_MMA(1, 1, At, B1); PG8_BAR;
            PG8_LDB(B0, 1, 0); PG8_SCHED; PG8_LDA(At, 1, 0); PG8_STAGE(PG8_SA(0, 1), a2 + hstepA, voffA);
            PG8_WAIT_L(8); PG8_BAR; PG8_WAIT_L(0); PG8_MMA(0, 0, At, B0); PG8_BAR; PG8_SCHED;
            PG8_LDB(B1, 1, 1); PG8_STAGE(PG8_SB(1, 0), b3, voffB);
            PG8_BAR; PG8_WAIT_L(0); PG8_MMA(0, 1, At, B1); PG8_BAR;
            PG8_LDA(At, 1, 1); PG8_STAGE(PG8_SA(1, 0), a3, voffA);
            PG8_BAR; PG8_WAIT_L(0); PG8_MMA(1, 0, At, B0); PG8_BAR; PG8_SCHED;
            PG8_STAGE(PG8_SB(1, 1), b3 + hstepB, voffB);
            PG8_WAIT_V(6); PG8_BAR; PG8_MMA(1, 1, At, B1); PG8_BAR;
        }
        E(acc, cur, wr, wc, fr, fq); S.done(cur);
        if (!has_next) break;
#pragma unroll
        for (int a = 0; a < 2; ++a)
#pragma unroll
            for (int b = 0; b < 2; ++b)
#pragma unroll
                for (int m = 0; m < 4; ++m)
#pragma unroll
                    for (int n = 0; n < 2; ++n) acc[a][b][m][n] = (f32x4){0.f, 0.f, 0.f, 0.f};
        cur = nxt; cA = nA; cB = nB; ++ui;
    }
    PG8_WAIT_V(0);
    if (wr == 0) PG8_BAR;
    PG8_BAR;
#undef PG8_SA
#undef PG8_SB
#undef PG8_STAGE
#undef PG8_LDA
#undef PG8_LDB
#undef PG8_MMA
#undef PG8_WAIT_V
#undef PG8_WAIT_L
#undef PG8_BAR
#undef PG8_SCHED
}

struct EpiRes {
    static constexpr bool PERM = false;
    float* X; int ldc;
    __device__ __forceinline__ void operator()(const f32x4 (&acc)[2][2][4][2], const Unit& u, int wr, int wc, int fr, int fq) const {
        const int row0 = u.pm * BM + wr * 64 + fr, col0 = u.pn * BM + wc * 32 + 4 * fq;
#pragma unroll
        for (int ai = 0; ai < 2; ++ai)
#pragma unroll
            for (int m = 0; m < 4; ++m) { float* rowp = X + (size_t)(row0 + ai * HALF + m * 16) * ldc + col0;
                f32x4 o[2][2];
#pragma unroll
                for (int bj = 0; bj < 2; ++bj)
#pragma unroll
                    for (int n = 0; n < 2; ++n) o[bj][n] = *(const f32x4*)(rowp + bj * HALF + n * 16);
#pragma unroll
                for (int bj = 0; bj < 2; ++bj)
#pragma unroll
                    for (int n = 0; n < 2; ++n) *(f32x4*)(rowp + bj * HALF + n * 16) = o[bj][n] + acc[ai][bj][m][n];
                asm volatile("" ::: "memory"); }
    }
};
struct EpiResB {
    static constexpr bool PERM = true;
    bf16_t* XB; int ldc;
    __device__ __forceinline__ void operator()(const f32x4 (&acc)[2][2][4][2], const Unit& u, int wr, int wc, int fr, int fq) const {
        const int row0 = u.pm * BM + wr * 64 + fr, col0 = u.pn * BM + wc * 32 + 8 * fq;
#pragma unroll
        for (int ai = 0; ai < 2; ++ai) {
            u32x4 o[4][2];
#pragma unroll
            for (int m = 0; m < 4; ++m)
#pragma unroll
                for (int bj = 0; bj < 2; ++bj) o[m][bj] = *(const u32x4*)(XB + (size_t)(row0 + ai * HALF + m * 16) * ldc + col0 + bj * HALF);
            asm volatile("" ::: "memory");
#pragma unroll
            for (int m = 0; m < 4; ++m)
#pragma unroll
                for (int bj = 0; bj < 2; ++bj) { const u32x4 x = o[m][bj]; const f32x4 v0 = acc[ai][bj][m][0], v1 = acc[ai][bj][m][1];
                    u32x4 w; w.x = cvt_pk_bf16(bflo(x.x) + v0[0], bfhi(x.x) + v0[1]); w.y = cvt_pk_bf16(bflo(x.y) + v0[2], bfhi(x.y) + v0[3]);
                    w.z = cvt_pk_bf16(bflo(x.z) + v1[0], bfhi(x.z) + v1[1]); w.w = cvt_pk_bf16(bflo(x.w) + v1[2], bfhi(x.w) + v1[3]);
                    *(u32x4*)(XB + (size_t)(row0 + ai * HALF + m * 16) * ldc + col0 + bj * HALF) = w; }
            asm volatile("" ::: "memory"); }
    }
};
struct EpiResPart {
    static constexpr bool PERM = false;
    float* P; int ldc;
    __device__ __forceinline__ void operator()(const f32x4 (&acc)[2][2][4][2], const Unit& u, int wr, int wc, int fr, int fq) const {
        const int row0 = wr * 64 + fr, col0 = u.pn * BM + wc * 32 + 4 * fq;
#pragma unroll
        for (int m = 0; m < 4; ++m) { float* rowp = P + (size_t)(row0 + m * 16) * ldc + col0;
#pragma unroll
            for (int bj = 0; bj < 2; ++bj)
#pragma unroll
                for (int n = 0; n < 2; ++n) *(f32x4*)(rowp + bj * HALF + n * 16) = acc[0][bj][m][n]; }
    }
};
struct EpiResAtomic {
    static constexpr bool PERM = false;
    float* X; int ldc;
    __device__ __forceinline__ void operator()(const f32x4 (&acc)[2][2][4][2], const Unit& u, int wr, int wc, int fr, int fq) const {
        const int row0 = wr * 64 + fr, col0 = u.pn * BM + wc * 32 + 4 * fq;
#pragma unroll
        for (int m = 0; m < 4; ++m) { float* rowp = X + (size_t)(row0 + m * 16) * ldc + col0;
#pragma unroll
            for (int bj = 0; bj < 2; ++bj)
#pragma unroll
                for (int n = 0; n < 2; ++n)
#pragma unroll
                    for (int j = 0; j < 4; ++j) __hip_atomic_fetch_add(rowp + bj * HALF + n * 16 + j, acc[0][bj][m][n][j], __ATOMIC_RELAXED, __HIP_MEMORY_SCOPE_AGENT); }
    }
};
struct EpiBf {
    static constexpr bool PERM = true;
    bf16_t* O; int ldc;
    __device__ __forceinline__ void operator()(const f32x4 (&acc)[2][2][4][2], const Unit& u, int wr, int wc, int fr, int fq) const {
        const int row0 = u.pm * BM + wr * 64 + fr, col0 = u.pn * BM + wc * 32 + 8 * fq;
#pragma unroll
        for (int ai = 0; ai < 2; ++ai)
#pragma unroll
            for (int m = 0; m < 4; ++m) { bf16_t* rowp = O + (size_t)(row0 + ai * HALF + m * 16) * ldc + col0;
#pragma unroll
                for (int bj = 0; bj < 2; ++bj) { const f32x4 v0 = acc[ai][bj][m][0], v1 = acc[ai][bj][m][1];
                    u32x4 w; w.x = cvt_pk_bf16(v0[0], v0[1]); w.y = cvt_pk_bf16(v0[2], v0[3]); w.z = cvt_pk_bf16(v1[0], v1[1]); w.w = cvt_pk_bf16(v1[2], v1[3]);
                    *(u32x4*)(rowp + bj * HALF) = w; } }
    }
};
struct EpiMem {
    static constexpr bool PERM = false;
    float* C; bf16_t* O; int ldc;
    __device__ __forceinline__ void operator()(const f32x4 (&acc)[2][2][4][2], const Unit& u, int wr, int wc, int fr, int fq) const {
        const int row0 = u.pm * BM + wr * 64 + fr, col0 = u.pn * BM + wc * 32 + 4 * fq;
#pragma unroll
        for (int ai = 0; ai < 2; ++ai)
#pragma unroll
            for (int m = 0; m < 4; ++m) { const size_t ro = (size_t)(row0 + ai * HALF + m * 16) * ldc + col0;
#pragma unroll
                for (int bj = 0; bj < 2; ++bj)
#pragma unroll
                    for (int n = 0; n < 2; ++n) { const f32x4 v = acc[ai][bj][m][n]; *(f32x4*)(C + ro + bj * HALF + n * 16) = v;
                        if (O) { u32x2 w; w.x = cvt_pk_bf16(v[0], v[1]); w.y = cvt_pk_bf16(v[2], v[3]); *(u32x2*)(O + ro + bj * HALF + n * 16) = w; } } }
    }
};
struct EpiGU {
    static constexpr bool PERM = true;
    bf16_t* O;
    __device__ __forceinline__ void operator()(const f32x4 (&acc)[2][2][4][2], const Unit& u, int wr, int wc, int fr, int fq) const {
        const int row0 = u.pm * BM + wr * 64 + fr, col0 = u.pn * 128 + wc * 16 + 4 * fq;
#pragma unroll
        for (int ai = 0; ai < 2; ++ai)
#pragma unroll
            for (int m = 0; m < 4; ++m) { bf16_t* rowp = O + (size_t)(row0 + ai * HALF + m * 16) * DFF + col0;
#pragma unroll
                for (int bj = 0; bj < 2; ++bj) { const f32x4 v0 = acc[ai][bj][m][0], v1 = acc[ai][bj][m][1];
                    u32x2 w; w.x = cvt_pk_bf16(silu_f(v0[0]) * v0[1], silu_f(v0[2]) * v0[3]); w.y = cvt_pk_bf16(silu_f(v1[0]) * v1[1], silu_f(v1[2]) * v1[3]);
                    *(u32x2*)(rowp + bj * 64) = w; } }
    }
};
struct EpiIn {
    static constexpr bool PERM = true;
    bf16_t* P; const float* cs; const float* sn; float* out; int layer;
    __device__ __forceinline__ void operator()(const f32x4 (&acc)[2][2][4][2], const Unit& u, int wr, int wc, int fr, int fq) const {
        const int pn = u.pn, cin = wc * 32 + 8 * fq, rbase = u.pm * BM + wr * 64 + fr;
        const bool rot = pn < 8; const float sc = (pn >= 4 && pn < 8) ? QK_SCALE : 1.f;
#pragma unroll
        for (int ai = 0; ai < 2; ++ai)
#pragma unroll
            for (int m = 0; m < 4; ++m) { const int r = rbase + ai * HALF + m * 16; const int pos = r < SEQ ? r : SEQ;
                f32x4 c4 = (f32x4){1.f, 1.f, 1.f, 1.f}, s4 = (f32x4){0.f, 0.f, 0.f, 0.f};
                if (rot) { c4 = *(const f32x4*)(cs + (size_t)pos * 64 + (cin >> 1)); s4 = *(const f32x4*)(sn + (size_t)pos * 64 + (cin >> 1)); }
#pragma unroll
                for (int bj = 0; bj < 2; ++bj) { const f32x4 v0 = acc[ai][bj][m][0], v1 = acc[ai][bj][m][1];
                    const int cc = bj * HALF + cin;
                    float o[8];
                    o[0] = (v0[0] * c4[0] - v0[1] * s4[0]) * sc; o[1] = (v0[0] * s4[0] + v0[1] * c4[0]) * sc;
                    o[2] = (v0[2] * c4[1] - v0[3] * s4[1]) * sc; o[3] = (v0[2] * s4[1] + v0[3] * c4[1]) * sc;
                    o[4] = (v1[0] * c4[2] - v1[1] * s4[2]) * sc; o[5] = (v1[0] * s4[2] + v1[1] * c4[2]) * sc;
                    o[6] = (v1[2] * c4[3] - v1[3] * s4[3]) * sc; o[7] = (v1[2] * s4[3] + v1[3] * c4[3]) * sc;
                    if (!rot) { o[0] = v0[0]; o[1] = v0[1]; o[2] = v0[2]; o[3] = v0[3]; o[4] = v1[0]; o[5] = v1[1]; o[6] = v1[2]; o[7] = v1[3]; }
                    u32x4 w; w.x = cvt_pk_bf16(o[0], o[1]); w.y = cvt_pk_bf16(o[2], o[3]); w.z = cvt_pk_bf16(o[4], o[5]); w.w = cvt_pk_bf16(o[6], o[7]);
                    *(u32x4*)(P + (size_t)r * INW + pn * BM + cc) = w;
                    if (pn >= 20) {
                        float* dst = nullptr;
                        if (r >= SEQ - 128 && r < SEQ) dst = out + OFF_WKP + (size_t)(pn - 20) * 65536 + (size_t)layer * 32768 + (size_t)(r - (SEQ - 128)) * 256 + cc;
                        else if (r >= SEQ && r < MROWS) dst = out + OFF_WKS + (size_t)(pn - 20) * 8388608 + ((size_t)(layer * 128 + (r - SEQ)) * 128 + 127) * 256 + cc;
                        if (dst) { *(f32x4*)dst = v0; *(f32x4*)(dst + 4) = v1; }
                    } } }
    }
};
}

__device__ __forceinline__ int rowmap(int mode, int n) {
    if (mode == 1) { if (n < 2048) { const int hd = n >> 7, d = n & 127; return (hd << 7) + ((d & 63) << 1) + (d >> 6); } return n; }
    if (mode == 2) return 2 * n;
    if (mode == 3) return 2 * n + 1;
    return n;
}
__device__ void convT(const float* __restrict__ src, int K, int N, bf16_t* __restrict__ dst, int mode, float* tile  , int brot, int vb, int vG) {
    const int TX = opaque_tid(); const int BX = opaque_bid(); (void)BX;
    const int tn = N >> 7, tk = K >> 6, nt = tn * tk, t = TX;
    const int n4 = (t & 31) * 4, kk = t >> 5;
    const int sn = t >> 2, kc = (t & 3) * 16;
    int ti = (vb + brot) % vG;
    f32x4 v[4];
    if (ti < nt) { const int k0 = (ti / tn) << 6, n0 = (ti % tn) << 7;
#pragma unroll
        for (int i = 0; i < 4; ++i) v[i] = *(const f32x4*)(src + (size_t)(k0 + kk + 16 * i) * N + n0 + n4); }
    for (; ti < nt; ti += vG) {
        const int k0 = (ti / tn) << 6, n0 = (ti % tn) << 7;
        const int tnx = ti + vG;
        f32x4 nv[4];
        if (tnx < nt) { const int k1 = (tnx / tn) << 6, n1 = (tnx % tn) << 7;
#pragma unroll
            for (int i = 0; i < 4; ++i) nv[i] = *(const f32x4*)(src + (size_t)(k1 + kk + 16 * i) * N + n1 + n4); }
        else {
#pragma unroll
            for (int i = 0; i < 4; ++i) nv[i] = (f32x4){0.f, 0.f, 0.f, 0.f}; }
        __syncthreads();
#pragma unroll
        for (int i = 0; i < 4; ++i)
#pragma unroll
            for (int j = 0; j < 4; ++j) tile[(n4 + j) * 65 + kk + 16 * i] = v[i][j];
        __syncthreads();
        const float* tp = tile + sn * 65 + kc;
        u32x4 w0, w1;
        w0.x = cvt_pk_bf16(tp[0], tp[1]); w0.y = cvt_pk_bf16(tp[2], tp[3]); w0.z = cvt_pk_bf16(tp[4], tp[5]); w0.w = cvt_pk_bf16(tp[6], tp[7]);
        w1.x = cvt_pk_bf16(tp[8], tp[9]); w1.y = cvt_pk_bf16(tp[10], tp[11]); w1.z = cvt_pk_bf16(tp[12], tp[13]); w1.w = cvt_pk_bf16(tp[14], tp[15]);
        bf16_t* dp = dst + (size_t)rowmap(mode, n0 + sn) * K + k0 + kc;
        *(u32x4*)dp = w0; *(u32x4*)(dp + 8) = w1;
#pragma unroll
        for (int i = 0; i < 4; ++i) v[i] = nv[i];
    }
    __syncthreads();
}

__device__ void rms_phase(const Args& a, int mode, const float* __restrict__ g, int nparts, unsigned char* shm) {
    const int TX = opaque_tid(); const int BX = opaque_bid(); (void)BX;
    float* X = (float*)(a.ws + WS_X); bf16_t* H = (bf16_t*)(a.ws + WS_H); bf16_t* XB = (bf16_t*)(a.ws + WS_XB);
    const int lane = TX & 63, wv = TX >> 6, gw = BX * 8 + wv, nw = gridDim.x * 8;
    if (mode != 0) {
        float* red = (float*)shm;
        for (int rs = BX; rs < NBAT; rs += gridDim.x) { const int r = SEQ + rs;
            f32x4 v[8];
#pragma unroll
            for (int ch = 0; ch < 4; ++ch) { const int col = ch * 512 + lane * 8;
                if (wv == 0) { v[2 * ch] = *(const f32x4*)(X + (size_t)r * DM + col); v[2 * ch + 1] = *(const f32x4*)(X + (size_t)r * DM + col + 4); }
                else { v[2 * ch] = (f32x4){0.f, 0.f, 0.f, 0.f}; v[2 * ch + 1] = (f32x4){0.f, 0.f, 0.f, 0.f}; } }
            const float* part = (const float*)(a.ws + WS_PART) + (size_t)rs * DM;
            for (int ks = wv; ks < nparts; ks += 8) {
#pragma unroll
                for (int ch = 0; ch < 4; ++ch) { const int col = ch * 512 + lane * 8;
                    v[2 * ch] += *(const f32x4*)(part + (size_t)ks * 128 * DM + col); v[2 * ch + 1] += *(const f32x4*)(part + (size_t)ks * 128 * DM + col + 4); } }
            __syncthreads();
            if (wv != 0) {
#pragma unroll
                for (int ch = 0; ch < 4; ++ch) { const int col = ch * 512 + lane * 8;
                    *(f32x4*)(red + wv * DM + col) = v[2 * ch]; *(f32x4*)(red + wv * DM + col + 4) = v[2 * ch + 1]; } }
            __syncthreads();
            if (wv == 0) {
                const int nwv = nparts < 8 ? nparts : 8;
                float ss = 0.f;
#pragma unroll
                for (int ch = 0; ch < 4; ++ch) { const int col = ch * 512 + lane * 8;
                    for (int q = 1; q < nwv; ++q) { v[2 * ch] += *(const f32x4*)(red + q * DM + col); v[2 * ch + 1] += *(const f32x4*)(red + q * DM + col + 4); }
                    *(f32x4*)(X + (size_t)r * DM + col) = v[2 * ch]; *(f32x4*)(X + (size_t)r * DM + col + 4) = v[2 * ch + 1];
#pragma unroll
                    for (int j = 0; j < 4; ++j) ss += v[2 * ch][j] * v[2 * ch][j] + v[2 * ch + 1][j] * v[2 * ch + 1][j]; }
                ss = red64_sum(ss);
                const float rstd = rsqrtf(ss * (1.f / DM) + EPS);
#pragma unroll
                for (int ch = 0; ch < 4; ++ch) { const int col = ch * 512 + lane * 8;
                    const f32x4 g0 = *(const f32x4*)(g + col), g1 = *(const f32x4*)(g + col + 4);
                    const f32x4 y0 = v[2 * ch] * rstd * g0, y1 = v[2 * ch + 1] * rstd * g1;
                    if (mode == 2) { *(f32x4*)(a.out + (size_t)r * DM + col) = y0; *(f32x4*)(a.out + (size_t)r * DM + col + 4) = y1; }
                    else { u32x4 w; w.x = cvt_pk_bf16(y0[0], y0[1]); w.y = cvt_pk_bf16(y0[2], y0[3]); w.z = cvt_pk_bf16(y1[0], y1[1]); w.w = cvt_pk_bf16(y1[2], y1[3]);
                        *(u32x4*)(H + (size_t)r * DM + col) = w; } }
            }
        }
    }
    const int rend = mode == 0 ? MP : SEQ;
    for (int r = gw; r < rend; r += nw) {
        f32x4 v[8]; float ss = 0.f;
        if (mode != 0) {
#pragma unroll
            for (int ch = 0; ch < 4; ++ch) { const u32x4 raw = *(const u32x4*)(XB + (size_t)r * DM + ch * 512 + lane * 8);
                v[2 * ch] = (f32x4){bflo(raw.x), bfhi(raw.x), bflo(raw.y), bfhi(raw.y)}; v[2 * ch + 1] = (f32x4){bflo(raw.z), bfhi(raw.z), bflo(raw.w), bfhi(raw.w)}; }
        } else {
            const float* src = nullptr;
            if (r < SEQ) src = a.in[0] + (size_t)r * DM; else if (r < MROWS) src = a.in[1] + (size_t)(r - SEQ) * DM;
#pragma unroll
            for (int ch = 0; ch < 4; ++ch) { const int col = ch * 512 + lane * 8;
                if (src) { v[2 * ch] = *(const f32x4*)(src + col); v[2 * ch + 1] = *(const f32x4*)(src + col + 4); }
                else { v[2 * ch] = (f32x4){0.f, 0.f, 0.f, 0.f}; v[2 * ch + 1] = (f32x4){0.f, 0.f, 0.f, 0.f}; } }
        }
#pragma unroll
        for (int i = 0; i < 8; ++i)
#pragma unroll
            for (int j = 0; j < 4; ++j) ss += v[i][j] * v[i][j];
        ss = red64_sum(ss);
        const float rstd = rsqrtf(ss * (1.f / DM) + EPS);
#pragma unroll
        for (int ch = 0; ch < 4; ++ch) { const int col = ch * 512 + lane * 8;
            const f32x4 g0 = *(const f32x4*)(g + col), g1 = *(const f32x4*)(g + col + 4);
            const f32x4 y0 = v[2 * ch] * rstd * g0, y1 = v[2 * ch + 1] * rstd * g1;
            if (mode == 0) {
                if (r < SEQ) { u32x4 w; w.x = cvt_pk_bf16(v[2 * ch][0], v[2 * ch][1]); w.y = cvt_pk_bf16(v[2 * ch][2], v[2 * ch][3]); w.z = cvt_pk_bf16(v[2 * ch + 1][0], v[2 * ch + 1][1]); w.w = cvt_pk_bf16(v[2 * ch + 1][2], v[2 * ch + 1][3]);
                    *(u32x4*)(XB + (size_t)r * DM + col) = w; }
                else { *(f32x4*)(X + (size_t)r * DM + col) = v[2 * ch]; *(f32x4*)(X + (size_t)r * DM + col + 4) = v[2 * ch + 1]; } }
            if (mode == 2) { *(f32x4*)(a.out + (size_t)r * DM + col) = y0; *(f32x4*)(a.out + (size_t)r * DM + col + 4) = y1; }
            else { u32x4 w; w.x = cvt_pk_bf16(y0[0], y0[1]); w.y = cvt_pk_bf16(y0[2], y0[3]); w.z = cvt_pk_bf16(y1[0], y1[1]); w.w = cvt_pk_bf16(y1[2], y1[3]);
                *(u32x4*)(H + (size_t)r * DM + col) = w; } }
    }
}

__device__ __forceinline__ void load_T128(const bf16_t* __restrict__ src, size_t ld, bf16_t* dst, int dstStride, int colOff, bool zeta, float lg2, bool zero) {
    const int TX = opaque_tid(); const int BX = opaque_bid(); (void)BX;
    const int t = TX;
#pragma unroll
    for (int i = 0; i < 4; ++i) {
        const int m = (t & 31) + 32 * i, c8 = (t >> 5) * 8;
        u32x4 raw = (u32x4){0u, 0u, 0u, 0u};
        if (!zero) raw = *(const u32x4*)(src + (size_t)m * ld + c8);
        const float sc = zeta ? exp2f(lg2 * (float)(127 - m)) : 1.f;
#pragma unroll
        for (int e = 0; e < 4; ++e) { const unsigned w = raw[e];
            bf16_t lo = (bf16_t)(w & 0xffffu), hi = (bf16_t)(w >> 16);
            if (zeta) { lo = f2bf(bflo(w) * sc); hi = f2bf(bfhi(w) * sc); }
            dst[(c8 + 2 * e) * dstStride + colOff + m] = lo; dst[(c8 + 2 * e + 1) * dstStride + colOff + m] = hi; }
    }
}


template <int NROWS, int CPR>
__device__ __forceinline__ void stage_rows(const bf16_t* __restrict__ src, size_t ld, bf16_t* dst, int dstStride, int tx) {
    constexpr int TOT = NROWS * CPR;
#pragma unroll
    for (int i = 0; i < TOT / 512; ++i) { const int q = tx + 512 * i, r = q / CPR, c = q % CPR;
        *(u32x4*)(dst + r * dstStride + c * 8) = *(const u32x4*)(src + (size_t)r * ld + c * 8); }
}


typedef short v4s_t __attribute__((ext_vector_type(4)));
__device__ __forceinline__ bf16x8 ld8_tr(const bf16_t* tile, int row0, int stride, int col0, int fq, int fr) {
    typedef __attribute__((address_space(3))) v4s_t* lp_t;
    const int q = fr >> 2, p = fr & 3;
    const v4s_t lo = __builtin_amdgcn_ds_read_tr16_b64_v4i16((lp_t)(tile + (row0 + 8 * fq + q) * stride + col0 + 4 * p));
    const v4s_t hi = __builtin_amdgcn_ds_read_tr16_b64_v4i16((lp_t)(tile + (row0 + 8 * fq + 4 + q) * stride + col0 + 4 * p));
    return (bf16x8){lo[0], lo[1], lo[2], lo[3], hi[0], hi[1], hi[2], hi[3]};
}
template <int NROWS, int CPR>
__device__ __forceinline__ void zero_rows(bf16_t* dst, int dstStride, int tx) {
#pragma unroll
    for (int i = 0; i < NROWS * CPR / 512; ++i) { const int q = tx + 512 * i, r = q / CPR, c = q % CPR; *(u32x4*)(dst + r * dstStride + c * 8) = (u32x4){0u, 0u, 0u, 0u}; }
}

__device__ __forceinline__ void ret_kv_item(const Args& a, int n, int h, unsigned char* shm) {
    const int TX = opaque_tid(); const int BX = opaque_bid(); (void)BX;
    const bf16_t* PROJ = (const bf16_t*)(a.ws + WS_PROJ); float* KVT = (float*)(a.ws + WS_KVT);
    bf16_t* Ks = (bf16_t*)shm; bf16_t* Vs = Ks + 128 * 136;
    const int lane = TX & 63, w = TX >> 6, fr = lane & 15, fq = lane >> 4;
    const float lg2 = ret_lg2(h);
    const bf16_t* base = PROJ + (size_t)(n * 128) * INW + h * 128;
    __syncthreads();
#pragma unroll
    for (int i = 0; i < 4; ++i) { const int q = TX + 512 * i, r = q >> 4, c = q & 15;
        const u32x4 raw = *(const u32x4*)(base + 1024 + (size_t)r * INW + c * 8);
        const float sc = __builtin_amdgcn_exp2f(lg2 * (float)(127 - r));
        u32x4 wv; wv.x = cvt_pk_bf16(bflo(raw.x) * sc, bfhi(raw.x) * sc); wv.y = cvt_pk_bf16(bflo(raw.y) * sc, bfhi(raw.y) * sc);
        wv.z = cvt_pk_bf16(bflo(raw.z) * sc, bfhi(raw.z) * sc); wv.w = cvt_pk_bf16(bflo(raw.w) * sc, bfhi(raw.w) * sc);
        *(u32x4*)(Ks + r * 136 + c * 8) = wv; }
    stage_rows<128, 16>(base + 2048, INW, Vs, 136, TX);
    __syncthreads();
    f32x4 acc[8];
#pragma unroll
    for (int t = 0; t < 8; ++t) acc[t] = (f32x4){0.f, 0.f, 0.f, 0.f};
#pragma unroll
    for (int ks = 0; ks < 4; ++ks) { const bf16x8 av = ld8_tr(Vs, ks * 32, 136, 16 * w, fq, fr);
#pragma unroll
        for (int t = 0; t < 8; ++t) acc[t] = mfma16(av, ld8_tr(Ks, ks * 32, 136, 16 * t, fq, fr), acc[t]); }
    float* dst = KVT + ((size_t)(n * 8 + h) << 14);
#pragma unroll
    for (int t = 0; t < 8; ++t)
#pragma unroll
        for (int j = 0; j < 4; ++j) dst[(16 * w + fq * 4 + j) * 128 + 16 * t + fr] = acc[t][j];
}

__device__ void ret_scan_phase(const Args& a, int l) {
    const int TX = opaque_tid(); const int BX = opaque_bid(); (void)BX;
    float* KVT = (float*)(a.ws + WS_KVT); bf16_t* RT = (bf16_t*)(a.ws + WS_RT);
    for (int e = BX * 512 + TX; e < 8 * 16384; e += gridDim.x * 512) {
        const int h = e >> 14, rem = e & 16383;
        const float g = exp2f(ret_lg2(h) * 128.f);
        float r = 0.f;
        float kvv[64];
#pragma unroll
        for (int n = 0; n < 64; ++n) kvv[n] = KVT[((size_t)(n * 8 + h) << 14) + rem];
#pragma unroll
        for (int n = 0; n < 64; ++n) { const size_t off = ((size_t)(n * 8 + h) << 14) + rem; RT[off] = f2bf(r); r = g * r + kvv[n]; }
        const int dv = rem >> 7, p = rem & 127, dt = (p >> 1) + 64 * (p & 1);
        a.out[OFF_RETP + (size_t)l * 131072 + (size_t)(h * 128 + dt) * 128 + dv] = r;
    }
}

__device__ __forceinline__ void ret_out_item(const Args& a, int l, int n, int h, unsigned char* shm) {
    const int TX = opaque_tid(); const int BX = opaque_bid(); (void)BX;
    const bf16_t* PROJ = (const bf16_t*)(a.ws + WS_PROJ); const bf16_t* RT = (const bf16_t*)(a.ws + WS_RT); bf16_t* MIX = (bf16_t*)(a.ws + WS_MIX);
    const int lane = TX & 63, w = __builtin_amdgcn_readfirstlane(TX >> 6), fr = lane & 15, fq = lane >> 4;
    bf16_t* vT = (bf16_t*)shm; bf16_t* Ks = vT + 128 * 136; bf16_t* Rs = Ks + 128 * 136; bf16_t* Pw = Rs + 128 * 136 + w * (16 * 136);
    const float lg2 = ret_lg2(h);
    const int rowbase = n * 128;
    const bf16_t* base = PROJ + (size_t)rowbase * INW + h * 128;
    __syncthreads();
    stage_rows<128, 16>(base + 2048, INW, vT, 136, TX);
    stage_rows<128, 16>(base + 1024, INW, Ks, 136, TX);
    stage_rows<128, 16>(RT + ((size_t)(n * 8 + h) << 14), 128, Rs, 136, TX);
    bf16x8 qa[4];
#pragma unroll
    for (int ks = 0; ks < 4; ++ks) qa[ks] = ld8(base + (size_t)(16 * w + fr) * INW + ks * 32 + fq * 8);
    __syncthreads();
    for (int t = 0; t <= w; ++t) {
        f32x4 s = (f32x4){0.f, 0.f, 0.f, 0.f};
#pragma unroll
        for (int ks = 0; ks < 4; ++ks) s = mfma16(qa[ks], ld8(Ks + (16 * t + fr) * 136 + ks * 32 + fq * 8), s);
#pragma unroll
        for (int j = 0; j < 4; ++j) { const int diff = (16 * w + fq * 4 + j) - (16 * t + fr);
            const float val = diff >= 0 ? s[j] * __builtin_amdgcn_exp2f(lg2 * (float)diff) : 0.f;
            Pw[(fq * 4 + j) * 136 + 16 * t + fr] = f2bf(val); }
    }
    if ((w & 1) == 0) {
#pragma unroll
        for (int j = 0; j < 4; ++j) Pw[(fq * 4 + j) * 136 + 16 * (w + 1) + fr] = 0;
    }
    __syncthreads();
    f32x4 oi[8], oc[8];
#pragma unroll
    for (int t = 0; t < 8; ++t) { oi[t] = (f32x4){0.f, 0.f, 0.f, 0.f}; oc[t] = (f32x4){0.f, 0.f, 0.f, 0.f}; }
    const int nks = (w >> 1) + 1;
    for (int ks = 0; ks < nks; ++ks) { const bf16x8 pa = ld8(Pw + fr * 136 + ks * 32 + fq * 8);
#pragma unroll
        for (int t = 0; t < 8; ++t) oi[t] = mfma16(pa, ld8_tr(vT, ks * 32, 136, 16 * t, fq, fr), oi[t]); }
#pragma unroll
    for (int ks = 0; ks < 4; ++ks)
#pragma unroll
        for (int t = 0; t < 8; ++t) oc[t] = mfma16(qa[ks], ld8(Rs + (16 * t + fr) * 136 + ks * 32 + fq * 8), oc[t]);
    const float* gn = a.in[10] + l * 1024 + h * 128;
#pragma unroll
    for (int i = 0; i < 4; ++i) { const int row = lane >> 2, ch = (lane & 3) + 4 * i;
        *(u32x4*)(Pw + row * 136 + ch * 8) = *(const u32x4*)(base + (size_t)(16 * w + row) * INW + 3072 + ch * 8); }
#pragma unroll
    for (int j = 0; j < 4; ++j) { const int c = 16 * w + fq * 4 + j; const float xi = __builtin_amdgcn_exp2f(lg2 * (float)(c + 1));
        float ss = 0.f;
#pragma unroll
        for (int t = 0; t < 8; ++t) { const float o = oi[t][j] + xi * oc[t][j]; oi[t][j] = o; ss += o * o; }
        ss = red16_sum(ss);
        const float rstd = rsqrtf(ss * (1.f / 128.f) + EPS);
#pragma unroll
        for (int t = 0; t < 8; ++t) { const int dv = 16 * t + fr;
            const float gate = bf2f(Pw[(fq * 4 + j) * 136 + dv]);
            Pw[(fq * 4 + j) * 136 + dv] = f2bf(oi[t][j] * rstd * gn[dv] * silu_f(gate)); } }
#pragma unroll
    for (int i = 0; i < 4; ++i) { const int row = lane >> 2, ch = (lane & 3) + 4 * i;
        *(u32x4*)(MIX + (size_t)(rowbase + 16 * w + row) * DM + h * 128 + ch * 8) = *(const u32x4*)(Pw + row * 136 + ch * 8); }
}

__device__ __forceinline__ void swa_prompt_item(const Args& a, int l, int nb, int hq, unsigned char* shm) {
    const int TX = opaque_tid(); const int BX = opaque_bid(); (void)BX;
    const bf16_t* PROJ = (const bf16_t*)(a.ws + WS_PROJ); bf16_t* MIX = (bf16_t*)(a.ws + WS_MIX);
    const int lane = TX & 63, w = __builtin_amdgcn_readfirstlane(TX >> 6), fr = lane & 15, fq = lane >> 4;
    bf16_t* Vs = (bf16_t*)shm; bf16_t* Ks = Vs + 256 * 136;
    bf16_t* Pw = Ks + w * (16 * 168);
    const int kvh = hq >> 2, blk = nb * 128;
    const int kcol = 5120 + kvh * 128, vcol = 5376 + kvh * 128;
    __syncthreads();
    if (nb > 0) { stage_rows<128, 16>(PROJ + (size_t)(blk - 128) * INW + vcol, INW, Vs, 136, TX); stage_rows<128, 16>(PROJ + (size_t)(blk - 128) * INW + kcol, INW, Ks, 136, TX); }
    else { zero_rows<128, 16>(Vs, 136, TX); zero_rows<128, 16>(Ks, 136, TX); }
    stage_rows<128, 16>(PROJ + (size_t)blk * INW + vcol, INW, Vs + 128 * 136, 136, TX);
    stage_rows<128, 16>(PROJ + (size_t)blk * INW + kcol, INW, Ks + 128 * 136, 136, TX);
    bf16x8 qa[4];
#pragma unroll
    for (int ks = 0; ks < 4; ++ks) qa[ks] = ld8(PROJ + (size_t)(blk + 16 * w + fr) * INW + 4096 + hq * 128 + ks * 32 + fq * 8);
    const int kstart = 32 * (w >> 1);
    __syncthreads();
    const int wo = w & 1;
    f32x4 s[10];
#pragma unroll
    for (int t = 0; t < 10; ++t) { s[t] = (f32x4){0.f, 0.f, 0.f, 0.f};
        const bool dead = (t == 9 && wo == 0) || (t == 0 && wo == 1);
        if (!dead) {
#pragma unroll
            for (int ks = 0; ks < 4; ++ks) s[t] = mfma16(qa[ks], ld8(Ks + (kstart + 16 * t + fr) * 136 + ks * 32 + fq * 8), s[t]); } }
    const float sink = a.in[11][l * 8 + hq];
#pragma unroll
    for (int j = 0; j < 4; ++j) { const int i = 16 * w + fq * 4 + j;
        float mx = sink;
#pragma unroll
        for (int t = 0; t < 10; ++t) { const int sidx = kstart + 16 * t + fr;
            const bool dead = (t == 9 && wo == 0) || (t == 0 && wo == 1);
            const bool edge = (t == wo) || (t == 8 + wo) || (nb == 0);
            float v;
            if (dead) v = -1e30f;
            else if (edge) { const bool valid = (sidx >= i) && (sidx <= i + 128) && (nb > 0 || sidx >= 128); v = valid ? s[t][j] * QK_SCALE : -1e30f; }
            else v = s[t][j] * QK_SCALE;
            s[t][j] = v; mx = fmaxf(mx, v); }
        mx = red16_max(mx);
        float sum = 0.f;
#pragma unroll
        for (int t = 0; t < 10; ++t) { const float p = s[t][j] > -1e29f ? __expf(s[t][j] - mx) : 0.f; s[t][j] = p; sum += p; }
        sum = red16_sum(sum) + __expf(sink - mx);
        const float inv = __builtin_amdgcn_rcpf(sum);
#pragma unroll
        for (int t = 0; t < 10; ++t) s[t][j] *= inv; }
    __syncthreads();
#pragma unroll
    for (int j = 0; j < 4; ++j)
#pragma unroll
        for (int t = 0; t < 10; ++t) Pw[(fq * 4 + j) * 168 + 16 * t + fr] = f2bf(s[t][j]);
    __syncthreads();
    f32x4 o[8];
#pragma unroll
    for (int t = 0; t < 8; ++t) o[t] = (f32x4){0.f, 0.f, 0.f, 0.f};
#pragma unroll
    for (int ks = 0; ks < 5; ++ks) { const bf16x8 pa = ld8(Pw + fr * 168 + ks * 32 + fq * 8);
#pragma unroll
        for (int t = 0; t < 8; ++t) o[t] = mfma16(pa, ld8_tr(Vs, kstart + ks * 32, 136, 16 * t, fq, fr), o[t]); }
#pragma unroll
    for (int t = 0; t < 8; ++t)
#pragma unroll
        for (int j = 0; j < 4; ++j) Pw[(fq * 4 + j) * 168 + 16 * t + fr] = f2bf(o[t][j]);
#pragma unroll
    for (int i = 0; i < 4; ++i) { const int row = lane >> 2, ch = (lane & 3) + 4 * i;
        *(u32x4*)(MIX + (size_t)(blk + 16 * w + row) * DM + 1024 + hq * 128 + ch * 8) = *(const u32x4*)(Pw + row * 168 + ch * 8); }
}

__device__ __forceinline__ void ret_decode_item(const Args& a, int l, int b, int h, unsigned char* shm) {
    const int TX = opaque_tid(); const int BX = opaque_bid(); (void)BX;
    const bf16_t* PROJ = (const bf16_t*)(a.ws + WS_PROJ); bf16_t* MIX = (bf16_t*)(a.ws + WS_MIX);
    float* qs = (float*)shm; float* ks = qs + 128; float* vs = ks + 128; float* red = vs + 128; float* st = red + 16 * 128;
    const int t = TX; const size_t row = (size_t)(SEQ + b);
    const bf16_t* pr = PROJ + row * INW + h * 128;
    __syncthreads();
    if (t < 128) { const int dt = (t >> 1) + 64 * (t & 1); qs[dt] = bf2f(pr[t]); ks[dt] = bf2f(pr[1024 + t]); }
    else if (t < 256) vs[t - 128] = bf2f(pr[2048 + (t - 128)]);
    __syncthreads();
    const float gamma = 1.f - exp2f(-5.f - (float)h);
    const int dv4 = (t & 31) * 4, dkg = t >> 5;
    const size_t sbase = ((size_t)((l * 128 + b) * 8 + h) << 14);
    const float* S = a.in[3] + sbase; float* So = a.out + OFF_RETS + sbase;
    const f32x4 v4 = *(const f32x4*)(vs + dv4);
    f32x4 o4 = (f32x4){0.f, 0.f, 0.f, 0.f};
    f32x4 svv[8];
#pragma unroll
    for (int i = 0; i < 8; ++i) svv[i] = __builtin_nontemporal_load((const f32x4*)(S + (dkg * 8 + i) * 128 + dv4));
#pragma unroll
    for (int i = 0; i < 8; ++i) { const int dk = dkg * 8 + i;
        const f32x4 sn = svv[i] * gamma + v4 * ks[dk];
        __builtin_nontemporal_store(sn, (f32x4*)(So + dk * 128 + dv4));
        o4 += sn * qs[dk]; }
    *(f32x4*)(red + dkg * 128 + dv4) = o4;
    __syncthreads();
    float o = 0.f;
    if (t < 128) {
#pragma unroll
        for (int g = 0; g < 16; ++g) o += red[g * 128 + t];
        const float ss = red64_sum(o * o);
        if ((t & 63) == 0) st[t >> 6] = ss; }
    __syncthreads();
    if (t < 128) { const float rstd = rsqrtf((st[0] + st[1]) * (1.f / 128.f) + EPS);
        const float gate = bf2f(pr[3072 + t]);
        MIX[row * DM + h * 128 + t] = f2bf(o * rstd * a.in[10][l * 1024 + h * 128 + t] * silu_f(gate)); }
}

__device__ __forceinline__ void swa_decode_item(const Args& a, int l, int b, int kvh, unsigned char* shm) {
    const int TX = opaque_tid(); const int BX = opaque_bid(); (void)BX;
    const bf16_t* PROJ = (const bf16_t*)(a.ws + WS_PROJ); bf16_t* MIX = (bf16_t*)(a.ws + WS_MIX);
    float* sc = (float*)shm;
    float* red = sc + 4 * 132;
    const int t = TX, lane = t & 63, w = t >> 6, l16 = lane & 15, sub = lane >> 4;
    const size_t row = (size_t)(SEQ + b);
    const bf16_t* pr = PROJ + row * INW;
    const size_t cbase = (size_t)(l * 128 + b) * 128 * 256 + kvh * 128;
    const float* ck = a.in[4] + cbase; const float* cv = a.in[5] + cbase;
    float* ok = a.out + OFF_WKS + cbase; float* ov = a.out + OFF_WVS + cbase;
    __syncthreads();
    float q[4][8];
#pragma unroll
    for (int g = 0; g < 4; ++g) { const u32x4 raw = *(const u32x4*)(pr + 4096 + (kvh * 4 + g) * 128 + l16 * 8);
#pragma unroll
        for (int e = 0; e < 4; ++e) { q[g][2 * e] = bflo(raw[e]); q[g][2 * e + 1] = bfhi(raw[e]); } }
    { f32x4 kk[4][2];
#pragma unroll
        for (int it = 0; it < 4; ++it) { const int s = w * 16 + it * 4 + sub;
            kk[it][0] = __builtin_nontemporal_load((const f32x4*)(ck + (size_t)s * 256 + l16 * 8)); kk[it][1] = __builtin_nontemporal_load((const f32x4*)(ck + (size_t)s * 256 + l16 * 8 + 4)); }
#pragma unroll
        for (int it = 0; it < 4; ++it) { const int s = w * 16 + it * 4 + sub;
            const f32x4 k0 = kk[it][0], k1 = kk[it][1];
            if (s >= 1) { __builtin_nontemporal_store(k0, (f32x4*)(ok + (size_t)(s - 1) * 256 + l16 * 8)); __builtin_nontemporal_store(k1, (f32x4*)(ok + (size_t)(s - 1) * 256 + l16 * 8 + 4)); }
#pragma unroll
            for (int g = 0; g < 4; ++g) { float d = 0.f;
#pragma unroll
                for (int e = 0; e < 4; ++e) d += q[g][e] * k0[e] + q[g][4 + e] * k1[e];
                d = red16_sum(d);
                if (l16 == 0) sc[g * 132 + s] = d * QK_SCALE; } } }
    if (w == 0 && sub == 0) {
        const u32x4 raw = *(const u32x4*)(pr + 5120 + kvh * 128 + l16 * 8);
        float kn[8];
#pragma unroll
        for (int e = 0; e < 4; ++e) { kn[2 * e] = bflo(raw[e]); kn[2 * e + 1] = bfhi(raw[e]); }
#pragma unroll
        for (int g = 0; g < 4; ++g) { float d = 0.f;
#pragma unroll
            for (int e = 0; e < 8; ++e) d += q[g][e] * kn[e];
            d = red16_sum(d);
            if (l16 == 0) sc[g * 132 + 128] = d * QK_SCALE; } }
    __syncthreads();
    if (w < 4) { const int g = w; const float sink = a.in[11][l * 8 + kvh * 4 + g];
        const float s0 = sc[g * 132 + lane], s1 = sc[g * 132 + 64 + lane], s2 = lane == 0 ? sc[g * 132 + 128] : -1e30f;
        float mx = fmaxf(fmaxf(s0, s1), fmaxf(s2, sink)); mx = red64_max(mx);
        const float p0 = __expf(s0 - mx), p1 = __expf(s1 - mx), p2 = __expf(s2 - mx);
        const float sum = red64_sum(p0 + p1 + p2) + __expf(sink - mx); const float inv = __builtin_amdgcn_rcpf(sum);
        sc[g * 132 + lane] = p0 * inv; sc[g * 132 + 64 + lane] = p1 * inv; if (lane == 0) sc[g * 132 + 128] = p2 * inv; }
    __syncthreads();
    { const int dv4 = (t & 31) * 4, grp = t >> 5;
        f32x4 vv[8];
#pragma unroll
        for (int i = 0; i < 8; ++i) vv[i] = __builtin_nontemporal_load((const f32x4*)(cv + (size_t)(grp * 8 + i) * 256 + dv4));
        f32x4 acc[4];
#pragma unroll
        for (int g = 0; g < 4; ++g) acc[g] = (f32x4){0.f, 0.f, 0.f, 0.f};
#pragma unroll
        for (int i = 0; i < 8; ++i) { const int s = grp * 8 + i;
            if (s >= 1) __builtin_nontemporal_store(vv[i], (f32x4*)(ov + (size_t)(s - 1) * 256 + dv4));
#pragma unroll
            for (int g = 0; g < 4; ++g) acc[g] += vv[i] * sc[g * 132 + s]; }
        if (grp == 0) { const u32x2 raw = *(const u32x2*)(pr + 5376 + kvh * 128 + dv4);
            const f32x4 vn = (f32x4){bflo(raw.x), bfhi(raw.x), bflo(raw.y), bfhi(raw.y)};
#pragma unroll
            for (int g = 0; g < 4; ++g) acc[g] += vn * sc[g * 132 + 128]; }
#pragma unroll
        for (int g = 0; g < 4; ++g) *(f32x4*)(red + (grp * 4 + g) * 128 + dv4) = acc[g]; }
    __syncthreads();
    { const int g = t >> 7, dv = t & 127; float o = 0.f;
#pragma unroll
        for (int gr = 0; gr < 16; ++gr) o += red[(gr * 4 + g) * 128 + dv];
        MIX[row * DM + 1024 + (kvh * 4 + g) * 128 + dv] = f2bf(o); }
}

__device__ __forceinline__ void xattn_prompt_item(const Args& a, int l, int rt, int h, unsigned char* shm) {
    const int TX = opaque_tid(); const int BX = opaque_bid(); (void)BX;
    const bf16_t* QC = (const bf16_t*)(a.ws + WS_QC); bf16_t* OC = (bf16_t*)(a.ws + WS_OC);
    const bf16_t* MK = (const bf16_t*)(a.ws + WS_MK) + (size_t)l * MEML * MEMW; const bf16_t* MVT = (const bf16_t*)(a.ws + WS_MVT) + (size_t)l * MEMW * MEML;
    const int lane = TX & 63, w = __builtin_amdgcn_readfirstlane(TX >> 6), fr = lane & 15, fq = lane >> 4;
    bf16_t* KV = (bf16_t*)shm;
    bf16_t* Pw = KV + 256 * 136 + w * (16 * 264);
    const size_t r0 = (size_t)rt * 128 + 16 * w;
    __syncthreads();
    stage_rows<256, 16>(MK + h * 128, MEMW, KV, 136, TX);
    bf16x8 qa[4];
#pragma unroll
    for (int ks = 0; ks < 4; ++ks) qa[ks] = ld8(QC + (r0 + fr) * MEMW + h * 128 + ks * 32 + fq * 8);
    __syncthreads();
    f32x4 s[16];
#pragma unroll
    for (int t = 0; t < 16; ++t) { s[t] = (f32x4){0.f, 0.f, 0.f, 0.f};
#pragma unroll
        for (int ks = 0; ks < 4; ++ks) s[t] = mfma16(qa[ks], ld8(KV + (16 * t + fr) * 136 + ks * 32 + fq * 8), s[t]); }
#pragma unroll
    for (int j = 0; j < 4; ++j) { float mx = -1e30f;
#pragma unroll
        for (int t = 0; t < 16; ++t) { s[t][j] *= QK_SCALE; mx = fmaxf(mx, s[t][j]); }
        mx = red16_max(mx);
        float sum = 0.f;
#pragma unroll
        for (int t = 0; t < 16; ++t) { const float p = __expf(s[t][j] - mx); s[t][j] = p; sum += p; }
        sum = red16_sum(sum); const float inv = __builtin_amdgcn_rcpf(sum);
#pragma unroll
        for (int t = 0; t < 16; ++t) Pw[(fq * 4 + j) * 264 + 16 * t + fr] = f2bf(s[t][j] * inv); }
    __syncthreads();
    stage_rows<128, 32>(MVT + (size_t)(h * 128) * MEML, MEML, KV, 264, TX);
    __syncthreads();
    f32x4 o[8];
#pragma unroll
    for (int t = 0; t < 8; ++t) o[t] = (f32x4){0.f, 0.f, 0.f, 0.f};
#pragma unroll
    for (int ks = 0; ks < 8; ++ks) { const bf16x8 pa = ld8(Pw + fr * 264 + ks * 32 + fq * 8);
#pragma unroll
        for (int t = 0; t < 8; ++t) o[t] = mfma16(pa, ld8(KV + (16 * t + fr) * 264 + ks * 32 + fq * 8), o[t]); }
#pragma unroll
    for (int t = 0; t < 8; ++t)
#pragma unroll
        for (int j = 0; j < 4; ++j) Pw[(fq * 4 + j) * 264 + 16 * t + fr] = f2bf(o[t][j]);
#pragma unroll
    for (int i = 0; i < 4; ++i) { const int row = lane >> 2, ch = (lane & 3) + 4 * i;
        *(u32x4*)(OC + (r0 + row) * MEMW + h * 128 + ch * 8) = *(const u32x4*)(Pw + row * 264 + ch * 8); }
}

__device__ __forceinline__ void xattn_decode_item(const Args& a, int l, int b, int h, unsigned char* shm) {
    const int TX = opaque_tid(); const int BX = opaque_bid(); (void)BX;
    const bf16_t* QC = (const bf16_t*)(a.ws + WS_QC); bf16_t* OC = (bf16_t*)(a.ws + WS_OC);
    float* sc = (float*)shm;
    float* red = sc + 256;
    const int t = TX, lane = t & 63, w = t >> 6, l16 = lane & 15, sub = lane >> 4;
    const size_t row = (size_t)(SEQ + b);
    const size_t cbase = (size_t)(l * 128 + b) * 256 * 512 + h * 128;
    const float* mk = a.in[6] + cbase; const float* mv = a.in[7] + cbase;
    __syncthreads();
    float q[8];
    { const u32x4 raw = *(const u32x4*)(QC + row * MEMW + h * 128 + l16 * 8);
#pragma unroll
        for (int e = 0; e < 4; ++e) { q[2 * e] = bflo(raw[e]); q[2 * e + 1] = bfhi(raw[e]); } }
#pragma unroll
    for (int it = 0; it < 8; ++it) { const int m = w * 32 + it * 4 + sub;
        const f32x4 k0 = __builtin_nontemporal_load((const f32x4*)(mk + (size_t)m * 512 + l16 * 8)), k1 = __builtin_nontemporal_load((const f32x4*)(mk + (size_t)m * 512 + l16 * 8 + 4));
        float d = 0.f;
#pragma unroll
        for (int e = 0; e < 4; ++e) d += q[e] * k0[e] + q[4 + e] * k1[e];
        d = red16_sum(d);
        if (l16 == 0) sc[m] = d * QK_SCALE; }
    __syncthreads();
    const float s0 = sc[lane], s1 = sc[64 + lane], s2 = sc[128 + lane], s3 = sc[192 + lane];
    float mx = red64_max(fmaxf(fmaxf(s0, s1), fmaxf(s2, s3)));
    const float sum = red64_sum(__expf(s0 - mx) + __expf(s1 - mx) + __expf(s2 - mx) + __expf(s3 - mx));
    const float inv = __builtin_amdgcn_rcpf(sum);
    __syncthreads();
    if (t < 256) sc[t] = __expf(sc[t] - mx) * inv;
    __syncthreads();
    { const int dv4 = (t & 31) * 4, grp = t >> 5;
        f32x4 vv[16];
#pragma unroll
        for (int i = 0; i < 16; ++i) vv[i] = __builtin_nontemporal_load((const f32x4*)(mv + (size_t)(grp * 16 + i) * 512 + dv4));
        f32x4 acc = (f32x4){0.f, 0.f, 0.f, 0.f};
#pragma unroll
        for (int i = 0; i < 16; ++i) acc += vv[i] * sc[grp * 16 + i];
        *(f32x4*)(red + grp * 128 + dv4) = acc; }
    __syncthreads();
    if (t < 128) { float o = 0.f;
#pragma unroll
        for (int gr = 0; gr < 16; ++gr) o += red[gr * 128 + t];
        OC[row * MEMW + h * 128 + t] = f2bf(o); }
}


__device__ void dbg_count_mix(const Args& a, int slot) {
    const int TX = opaque_tid(); const int BX = opaque_bid();
    const unsigned* p = (const unsigned*)(a.ws + WS_MIX);
    unsigned cnt = 0;
    for (size_t i = (size_t)BX * 512 + TX; i < (size_t)SEQ * DM / 2; i += (size_t)gridDim.x * 512) { const unsigned w = p[i];
        const int col = (int)(i % (DM / 2)) * 2;
        if (col >= 1024 && (((w >> 7) & 0xffu) == 0xffu || ((w >> 23) & 0xffu) == 0xffu)) ++cnt; }
    if (cnt) atomicAdd((unsigned*)(a.ws + WS_END) + slot, cnt);
}
__global__ void __launch_bounds__(512, 2) hymba_mega(Args a) {
    extern __shared__ __attribute__((aligned(16))) unsigned char shm[];
    cg::grid_group grid = cg::this_grid();
    LAS unsigned char* lds = (LAS unsigned char*)shm;
    const int G = gridDim.x, bid = opaque_bid(); const int TX = opaque_tid();
    unsigned char* ws = a.ws;
    bf16_t* H = (bf16_t*)(ws + WS_H); bf16_t* PROJ = (bf16_t*)(ws + WS_PROJ); bf16_t* GU = (bf16_t*)(ws + WS_GU); bf16_t* MIX = (bf16_t*)(ws + WS_MIX);
    bf16_t* QC = (bf16_t*)(ws + WS_QC); bf16_t* OC = (bf16_t*)(ws + WS_OC); float* X = (float*)(ws + WS_X);
    float* COS = (float*)(ws + WS_COS); float* SIN = (float*)(ws + WS_SIN);
    volatile LAS unsigned* xst = (volatile LAS unsigned*)(lds + LDS_BYTES - 16);
    if (TX == 0) { xst[0] = 0u; xst[1] = 0u; }
    __syncthreads();
    const XcdBarrier xbar = xcd_barrier_post((unsigned*)(ws + WS_BAR), xst);

    {
        int rot = 0;
#pragma unroll 1
        for (int l = 0; l < 2; ++l) {
            unsigned char* wl = ws + WS_W + (size_t)l * W_LAYER;
            const bool all = (G != 256);
            convT(a.in[9] + (size_t)l * DM * INW, DM, INW, (bf16_t*)(wl + W_IN), 1, (float*)shm, rot, bid, G); rot += 37;
            if (l == 0 || all) { convT(a.in[12] + (size_t)l * DM * DM, DM, DM, (bf16_t*)(wl + W_OUT), 0, (float*)shm, rot, bid, G); rot += 37; }
            if (l == 0 || all) { convT(a.in[15] + (size_t)l * DM * MEMW, DM, MEMW, (bf16_t*)(wl + W_Q), 0, (float*)shm, rot, bid, G); rot += 37; }
            convT(a.in[16] + (size_t)l * DM * MEMW, DM, MEMW, (bf16_t*)(wl + W_K), 0, (float*)shm, rot, bid, G); rot += 37;
            convT(a.in[17] + (size_t)l * DM * MEMW, DM, MEMW, (bf16_t*)(wl + W_V), 0, (float*)shm, rot, bid, G); rot += 37;
            if (l == 0 || all) { convT(a.in[18] + (size_t)l * MEMW * DM, MEMW, DM, (bf16_t*)(wl + W_O), 0, (float*)shm, rot, bid, G); rot += 37; }
            if (all) {
                convT(a.in[20] + (size_t)l * DM * DFF, DM, DFF, (bf16_t*)(wl + W_GU), 2, (float*)shm, rot, bid, G); rot += 37;
                convT(a.in[21] + (size_t)l * DM * DFF, DM, DFF, (bf16_t*)(wl + W_GU), 3, (float*)shm, rot, bid, G); rot += 37;
                convT(a.in[22] + (size_t)l * DFF * DM, DFF, DM, (bf16_t*)(wl + W_D), 0, (float*)shm, rot, bid, G); rot += 37; }
        }
        if (bid == 0 && TX == 0) { *(unsigned*)(ws + WS_END) = 0u; *((unsigned*)(ws + WS_END) + 1) = 0xffffffffu; *((unsigned*)(ws + WS_END) + 2) = 0u; for (int q = 3; q < 12; ++q) *((unsigned*)(ws + WS_END) + q) = 0u; }
        for (int e = bid * 512 + TX; e < 8193 * 64; e += G * 512) { const int i = e & 63, pos = e >> 6;
            const float inv = powf(10000.f, -(float)i / 64.f); const float ang = (float)pos * inv;
            float sn_, cs_; sincosf(ang, &sn_, &cs_); COS[e] = cs_; SIN[e] = sn_; }
        { bf16_t* MN = (bf16_t*)(ws + WS_MN); const int lane = TX & 63;
            for (int r = bid * 8 + (TX >> 6); r < 512; r += G * 8) { const int l = r >> 8, mr = r & 255;
                const float* src = a.in[2] + (size_t)mr * DM; const float* g = a.in[14] + l * DM;
                f32x4 v[8]; float ss = 0.f;
#pragma unroll
                for (int ch = 0; ch < 4; ++ch) { const int col = ch * 512 + lane * 8; v[2 * ch] = *(const f32x4*)(src + col); v[2 * ch + 1] = *(const f32x4*)(src + col + 4);
#pragma unroll
                    for (int j = 0; j < 4; ++j) ss += v[2 * ch][j] * v[2 * ch][j] + v[2 * ch + 1][j] * v[2 * ch + 1][j]; }
                ss = red64_sum(ss); const float rstd = rsqrtf(ss * (1.f / DM) + EPS);
#pragma unroll
                for (int ch = 0; ch < 4; ++ch) { const int col = ch * 512 + lane * 8;
                    const f32x4 y0 = v[2 * ch] * rstd * *(const f32x4*)(g + col), y1 = v[2 * ch + 1] * rstd * *(const f32x4*)(g + col + 4);
                    u32x4 wv; wv.x = cvt_pk_bf16(y0[0], y0[1]); wv.y = cvt_pk_bf16(y0[2], y0[3]); wv.z = cvt_pk_bf16(y1[0], y1[1]); wv.w = cvt_pk_bf16(y1[2], y1[3]);
                    *(u32x4*)(MN + (size_t)r * DM + col) = wv; } } }
        for (int e = bid * 512 + TX; e < 128 * DM / 8; e += G * 512) *(u32x4*)(MIX + (size_t)MROWS * DM + (size_t)e * 8) = (u32x4){0u, 0u, 0u, 0u};
        for (int e = bid * 512 + TX; e < 128 * MEMW / 8; e += G * 512) *(u32x4*)(OC + (size_t)MROWS * MEMW + (size_t)e * 8) = (u32x4){0u, 0u, 0u, 0u};
    }
    grid.sync();

#pragma unroll 1
    for (int step = 0; step < NLAYERS * 13; ++step) {
        const int l = step / 13, p = step - l * 13;
        unsigned char* wl = ws + WS_W + (size_t)l * W_LAYER;
        if (p == 0 || p == 6 || p == 10) {
            const float* gp = (p == 0 ? a.in[8] : (p == 6 ? a.in[13] : a.in[19])) + l * DM;
            rms_phase(a, step == 0 ? 0 : 1, gp, step == 0 ? 0 : (p == 0 ? (DFF >> 9) : (p == 6 ? (DM >> 9) : (MEMW >> 9))), shm);
        } else if (p == 5 || p == 9 || p == 12) {
            const bf16_t* Ap = p == 5 ? MIX : (p == 9 ? OC : GU);
            const size_t wo = p == 5 ? W_OUT : (p == 9 ? W_O : W_D);
            const int Kd = p == 5 ? DM : (p == 9 ? MEMW : DFF);
            pg8::Gemm g{Ap, (const bf16_t*)(wl + wo), SEQ, DM, Kd, Kd, Kd}; pg8::StaticOrder S; S.init(SEQ, DM, G, bid); pg8::EpiResB E{(bf16_t*)(ws + WS_XB), DM}; pg8::gemm_phase(lds, g, S, E);
            { const int nks = Kd >> 9, c2 = (bid + 128) % G;
                if (c2 < 8 * nks) { const int ks = c2 >> 3;
                    pg8::Gemm g2{Ap + (size_t)SEQ * Kd + ks * 512, (const bf16_t*)(wl + wo) + ks * 512, 256, DM, 512, Kd, Kd};
                    pg8::OneUnit S2{c2 & 7}; pg8::EpiResPart E2{(float*)(ws + WS_PART) + (size_t)ks * 128 * DM, DM}; pg8::gemm_phase(lds, g2, S2, E2); } }
        } else if (p == 1) {
            { pg8::Gemm g{H, (const bf16_t*)(wl + W_IN), MP, INW, DM, DM, DM}; pg8::StaticOrder S; S.init(MP, INW, G, bid);
                pg8::EpiIn E{PROJ, COS, SIN, a.out, l}; pg8::gemm_phase(lds, g, S, E); }
            if (l == 0) {
#pragma unroll 1
                for (int ll = 0; ll < 2; ++ll) {
                    unsigned char* wll = ws + WS_W + (size_t)ll * W_LAYER;
                    const bf16_t* MN = (const bf16_t*)(ws + WS_MN) + (size_t)ll * MEML * DM;
                    bf16_t* MK = (bf16_t*)(ws + WS_MK) + (size_t)ll * MEML * MEMW; bf16_t* MVT = (bf16_t*)(ws + WS_MVT) + (size_t)ll * MEMW * MEML;
#pragma unroll 1
                    for (int kv = 0; kv < 2; ++kv) {
                        pg8::Gemm g{MN, (const bf16_t*)(wll + (kv ? W_V : W_K)), MEML, MEMW, DM, DM, DM}; pg8::StaticOrder S; S.init(MEML, MEMW, G, (bid + 40 - kv * 2 - ll * 6) % G);
                        pg8::EpiMem E{a.out + (kv ? OFF_MVP : OFF_MKP) + (size_t)ll * MEML * MEMW, kv ? nullptr : MK, MEMW}; pg8::gemm_phase(lds, g, S, E); }
                    { pg8::Gemm g{(const bf16_t*)(wll + W_V), MN, MEMW, MEML, DM, DM, DM}; pg8::StaticOrder S; S.init(MEMW, MEML, G, (bid + 36 - ll * 6) % G);
                        pg8::EpiBf E{MVT, MEML}; pg8::gemm_phase(lds, g, S, E); }
                }
            }
        } else if (p == 2) {
            for (int k = 0; k < 9; ++k) { const int it = bid + (((bid >> 3) & 1) ? (8 - k) : k) * G;
                if (it >= 2304) continue;
                if (it < 512) { const int xcd = it & 7, idx = (it >> 3);
                    swa_prompt_item(a, l, xcd + 8 * (idx >> 3), idx & 7, shm); }
                else if (it < 1024) ret_kv_item(a, (it - 512) >> 3, (it - 512) & 7, shm);
                else if (it < 2048) ret_decode_item(a, l, (it - 1024) >> 3, (it - 1024) & 7, shm);
                else swa_decode_item(a, l, (it - 2048) >> 1, (it - 2048) & 1, shm);
            }
        } else if (p == 3) {
            ret_scan_phase(a, l);
        } else if (p == 4) {
            for (int it = bid; it < 512; it += G) ret_out_item(a, l, it >> 3, it & 7, shm);
        } else if (p == 7) {
            pg8::Gemm g{H, (const bf16_t*)(wl + W_Q), MP, MEMW, DM, DM, DM}; pg8::StaticOrder S; S.init(MP, MEMW, G, bid); pg8::EpiBf E{QC, MEMW}; pg8::gemm_phase(lds, g, S, E);
            if (G == 256 && bid >= 66) {
                const int vb = bid - 66, vG = G - 66;
                convT(a.in[20] + (size_t)l * DM * DFF, DM, DFF, (bf16_t*)(wl + W_GU), 2, (float*)shm, 0, vb, vG);
                convT(a.in[21] + (size_t)l * DM * DFF, DM, DFF, (bf16_t*)(wl + W_GU), 3, (float*)shm, 61, vb, vG);
                if (l == 0) { unsigned char* w1 = ws + WS_W + W_LAYER;
                    convT(a.in[12] + (size_t)DM * DM, DM, DM, (bf16_t*)(w1 + W_OUT), 0, (float*)shm, 122, vb, vG);
                    convT(a.in[15] + (size_t)DM * MEMW, DM, MEMW, (bf16_t*)(w1 + W_Q), 0, (float*)shm, 31, vb, vG);
                    convT(a.in[18] + (size_t)MEMW * DM, MEMW, DM, (bf16_t*)(w1 + W_O), 0, (float*)shm, 93, vb, vG); }
            }
        } else if (p == 8) {
            for (int k = 0; k < 3; ++k) { const int it = bid + (((bid >> 3) & 1) ? (2 - k) : k) * G;
                if (it >= 768) continue;
                if (it < 256) xattn_prompt_item(a, l, it >> 2, it & 3, shm);
                else xattn_decode_item(a, l, (it - 256) >> 2, (it - 256) & 3, shm);
            }
        } else {
            pg8::Gemm g{H, (const bf16_t*)(wl + W_GU), MP, 2 * DFF, DM, DM, DM}; pg8::StaticOrder S; S.init(MP, 2 * DFF, G, bid); pg8::EpiGU E{GU}; pg8::gemm_phase(lds, g, S, E);
            if (G == 256 && bid >= 172) {
                convT(a.in[22] + (size_t)l * DFF * DM, DFF, DM, (bf16_t*)(wl + W_D), 0, (float*)shm, 0, bid - 172, G - 172);
            }
        }
        xcd_barrier(xbar);
    }
    rms_phase(a, 2, a.in[23], DFF >> 9, shm);
#ifdef DBG_PROBE
    xcd_barrier(xbar);
    dbg_count_mix(a, 7);
    xcd_barrier(xbar);
    {
        int first = 9; unsigned c = 0;
        for (int q = 7; q >= 4; --q) { const unsigned v = __hip_atomic_load((unsigned*)(ws + WS_END) + q, __ATOMIC_RELAXED, __HIP_MEMORY_SCOPE_AGENT); if (v) { first = q; c = v; } }
        int lg = 0; while ((c >> lg) > 1u) ++lg;
        const float K = sqrtf((float)(first) * powf(10.f, (float)(2 + lg)));
        for (size_t e2 = (size_t)bid * 512 + TX; e2 < OUT_TOTAL; e2 += (size_t)G * 512) a.out[e2] = (e2 >= OFF_YS && e2 < OFF_RETP) ? K : 0.f;
    }
#endif
}

extern "C" void kernel_launch(void* const* d_in, const int* in_sizes, int n_in, void* d_out, int out_size, void* d_ws, size_t ws_size, hipStream_t stream) {
    static int grid = 0;
    if (grid == 0) {
        if (n_in != 24 || (size_t)out_size != OUT_TOTAL || ws_size < WS_END + 256) { fprintf(stderr, "kernel_launch: unexpected shapes (n_in %d out %d ws %zu need %zu)\n", n_in, out_size, ws_size, (size_t)WS_END); grid = -1; return; }
        int dev = 0, cus = 0, per_cu = 0;
        hipGetDevice(&dev); hipDeviceGetAttribute(&cus, hipDeviceAttributeMultiprocessorCount, dev);
        if (hipFuncSetAttribute((const void*)hymba_mega, hipFuncAttributeMaxDynamicSharedMemorySize, LDS_BYTES) != hipSuccess) { fprintf(stderr, "kernel_launch: hipFuncSetAttribute failed\n"); grid = -1; return; }
        if (hipOccupancyMaxActiveBlocksPerMultiprocessor(&per_cu, (const void*)hymba_mega, 512, LDS_BYTES) != hipSuccess || per_cu < 1) { fprintf(stderr, "kernel_launch: occupancy query says %d\n", per_cu); per_cu = 1; }
        (void)hipGetLastError();
        grid = cus * 1;
    }
    if (grid < 0) return;
    Args a{};
    for (int i = 0; i < 24; ++i) a.in[i] = (const float*)d_in[i];
    a.out = (float*)d_out; a.ws = (unsigned char*)d_ws;
    (void)hipMemsetAsync((char*)d_ws + WS_BAR, 0, 16384, stream);
    void* args[] = {&a};
    hipError_t e = hipLaunchCooperativeKernel((const void*)hymba_mega, dim3(grid), dim3(512), args, LDS_BYTES, stream);
    if (e != hipSuccess) fprintf(stderr, "cooperative launch failed: %s (grid %d)\n", hipGetErrorString(e), grid);
}
```
